# Optimizing an MI355X kernel written in HIP

```python
import math
import jax, jax.numpy as jnp
from jax import lax
import numpy as np

D_MODEL = 1024
BATCH = 4
SEQ = 8192
DEPTH = 2

ROPE_THETA = 500000.0
RMS_EPS = 1e-6
Q_BLOCK = 128
CONV_WIDTH = 3
D_CONV = D_MODEL // 2
MLA_HEADS = 8
MLA_NOPE = 64
MLA_ROPE = 32
MLA_V = 64
MLA_Q_LORA = 3 * D_MODEL // 8
MLA_KV_LORA = D_MODEL // 4
NSA_HEADS = 8
NSA_GROUPS = 2
NSA_HPG = NSA_HEADS // NSA_GROUPS
NSA_DIM = 64
NSA_ROT = NSA_DIM // 4
CMP_LEN = 32
CMP_STRIDE = 16
SEL_LEN = 64
N_SEL = 16
WINDOW = 512
FORCED_SCORE = 1e6
D_FF = 2816
IN_SPLITS = (D_MODEL, D_MODEL, D_MODEL,
             D_CONV, D_CONV, D_CONV,
             MLA_Q_LORA, MLA_KV_LORA, MLA_ROPE,
             NSA_HEADS * NSA_DIM,
             NSA_GROUPS * NSA_DIM, NSA_GROUPS * NSA_DIM,
             NSA_GROUPS * NSA_DIM, NSA_GROUPS * NSA_DIM,
             NSA_GROUPS * NSA_DIM, NSA_GROUPS * NSA_DIM,
             3 * NSA_HEADS)
N_IN = sum(IN_SPLITS)
SPLIT_POINTS = tuple(int(v) for v in np.cumsum(IN_SPLITS)[:-1])

kernel_name = 'hybrid_conv_mla_nsa_block'


def rms_norm(x, g):
    x32 = x.astype(jnp.float32)
    y = x32 * lax.rsqrt(jnp.mean(x32 * x32, axis=-1, keepdims=True) + RMS_EPS)
    return (y * g.astype(jnp.float32)).astype(x.dtype)


def masked_softmax(s, mask):
    s = jnp.where(mask, s.astype(jnp.float32), -1e30)
    return jnp.where(mask, jax.nn.softmax(s, axis=-1), 0.0)


def rope(x, positions, rot_dim):
    half = rot_dim // 2
    inv_freq = ROPE_THETA ** (-jnp.arange(half, dtype=jnp.float32) / half)
    ang = positions.astype(jnp.float32)[..., None] * inv_freq
    cos = jnp.cos(ang)[:, :, None, :]
    sin = jnp.sin(ang)[:, :, None, :]
    x1 = x[..., :half].astype(jnp.float32)
    x2 = x[..., half:rot_dim].astype(jnp.float32)
    rot = jnp.concatenate([x1 * cos - x2 * sin, x2 * cos + x1 * sin], axis=-1).astype(x.dtype)
    return jnp.concatenate([rot, x[..., rot_dim:]], axis=-1)


def causal_dwconv(u, w, b=None):
    S = u.shape[1]
    up = jnp.pad(u, ((0, 0), (CONV_WIDTH - 1, 0), (0, 0)))
    y = up[:, 0:S] * w[0]
    for k in range(1, CONV_WIDTH):
        y = y + up[:, k:k + S] * w[k]
    return y if b is None else y + b


def short_conv_mixer(b_gate, c_gate, x_in, conv_w):
    return b_gate * causal_dwconv(c_gate * x_in, conv_w)


def mla_mixer(c_q, c_kv, k_r, positions, q_norm, w_uq, kv_norm, w_ukv):
    B, S, _ = c_q.shape
    q = (rms_norm(c_q, q_norm) @ w_uq).reshape(B, S, MLA_HEADS, MLA_NOPE + MLA_ROPE)
    q_nope = q[..., :MLA_NOPE]
    q_rope = rope(q[..., MLA_NOPE:], positions, MLA_ROPE)
    kv = (rms_norm(c_kv, kv_norm) @ w_ukv).reshape(B, S, MLA_HEADS, MLA_NOPE + MLA_V)
    k_nope = kv[..., :MLA_NOPE]
    v = kv[..., MLA_NOPE:]
    k_rope = rope(k_r[:, :, None, :], positions, MLA_ROPE)[:, :, 0, :]
    scale = (MLA_NOPE + MLA_ROPE) ** -0.5
    kpos = jnp.arange(S)

    def block(i):
        s0 = i * Q_BLOCK
        qn = lax.dynamic_slice_in_dim(q_nope, s0, Q_BLOCK, axis=1)
        qr = lax.dynamic_slice_in_dim(q_rope, s0, Q_BLOCK, axis=1)
        s = (jnp.einsum('bqhd,bkhd->bhqk', qn, k_nope)
             + jnp.einsum('bqhd,bkd->bhqk', qr, k_rope)) * scale
        t = s0 + jnp.arange(Q_BLOCK)
        p = masked_softmax(s, kpos[None, :] <= t[:, None])
        return jnp.einsum('bhqk,bkhd->bqhd', p.astype(v.dtype), v)

    o = lax.map(block, jnp.arange(S // Q_BLOCK))
    return o.transpose(1, 0, 2, 3, 4).reshape(B, S, MLA_HEADS * MLA_V)


def nsa_mixer(q, k_cmp, v_cmp, k_slc, v_slc, k_win, v_win, gate_logits, positions,
              pos_k, pos_v, w_ck, w_cv):
    B, S, _ = q.shape
    G, J, dk = NSA_GROUPS, NSA_HPG, NSA_DIM
    q = rope(q.reshape(B, S, NSA_HEADS, dk), positions, NSA_ROT).reshape(B, S, G, J, dk)

    def kv_heads(t):
        return t.reshape(B, S, G, dk)

    k_cmp = rope(kv_heads(k_cmp), positions, NSA_ROT)
    k_slc = rope(kv_heads(k_slc), positions, NSA_ROT)
    k_win = rope(kv_heads(k_win), positions, NSA_ROT)
    v_cmp, v_slc, v_win = kv_heads(v_cmp), kv_heads(v_slc), kv_heads(v_win)

    n_cmp = (S - CMP_LEN) // CMP_STRIDE + 1
    idx = jnp.arange(n_cmp)[:, None] * CMP_STRIDE + jnp.arange(CMP_LEN)[None, :]

    def compress(t, pos, w):
        blocks = t[:, idx] + pos[None, None, :, None, :]
        return jnp.einsum('bnrgd,rde->bnge', blocks, w.reshape(CMP_LEN, dk, dk))

    kc = compress(k_cmp, pos_k, w_ck)
    vc = compress(v_cmp, pos_v, w_cv)
    cmp_end = jnp.arange(n_cmp) * CMP_STRIDE + CMP_LEN - 1

    n_sel = S // SEL_LEN
    n_top = min(N_SEL, n_sel)
    kb = k_slc.reshape(B, n_sel, SEL_LEN, G, dk).transpose(0, 3, 1, 2, 4)
    vb = v_slc.reshape(B, n_sel, SEL_LEN, G, dk).transpose(0, 3, 1, 2, 4)
    cmp_start = jnp.arange(n_cmp)[:, None] * CMP_STRIDE
    sel_start = jnp.arange(n_sel)[None, :] * SEL_LEN
    overlap = ((cmp_start <= sel_start + SEL_LEN - 1)
               & (cmp_start + CMP_LEN - 1 >= sel_start)).astype(jnp.float32)
    sel_id = jnp.arange(n_sel)
    bi = jnp.arange(B)[:, None, None, None]
    gi = jnp.arange(G)[None, :, None, None]

    pad = ((0, 0), (WINDOW, 0), (0, 0), (0, 0))
    kw = jnp.pad(k_win, pad)
    vw = jnp.pad(v_win, pad)

    gates = jax.nn.sigmoid(gate_logits.reshape(B, S, G, J, 3))
    scale = dk ** -0.5

    def block(i):
        s0 = i * Q_BLOCK
        qb = lax.dynamic_slice_in_dim(q, s0, Q_BLOCK, axis=1)
        gb = lax.dynamic_slice_in_dim(gates, s0, Q_BLOCK, axis=1)
        t = s0 + jnp.arange(Q_BLOCK)
        sc = jnp.einsum('bqgjd,bngd->bgjqn', qb, kc) * scale
        pc = masked_softmax(sc, cmp_end[None, :] <= t[:, None])
        o_cmp = jnp.einsum('bgjqn,bngd->bqgjd', pc.astype(vc.dtype), vc)
        imp = jnp.einsum('bgjqn,nm->bgqm', pc, overlap)
        cur = t // SEL_LEN
        forced = ((sel_id[None, :] == 0) | (sel_id[None, :] == cur[:, None])
                  | (sel_id[None, :] == cur[:, None] - 1))
        causal = sel_id[None, :] * SEL_LEN <= t[:, None]
        imp = jnp.where(forced, FORCED_SCORE, jnp.where(causal, imp, -1.0))
        top_val, top_idx = lax.top_k(imp, n_top)
        ks = kb[bi, gi, top_idx]
        vs = vb[bi, gi, top_idx]
        kpos = top_idx[..., None] * SEL_LEN + jnp.arange(SEL_LEN)
        smask = (top_val >= 0)[..., None] & (kpos <= t[None, None, :, None, None])
        ss = jnp.einsum('bqgjd,bgqnrd->bgjqnr', qb, ks) * scale
        ps = masked_softmax(ss.reshape(B, G, J, Q_BLOCK, n_top * SEL_LEN),
                            smask.reshape(B, G, 1, Q_BLOCK, n_top * SEL_LEN)).reshape(ss.shape)
        o_slc = jnp.einsum('bgjqnr,bgqnrd->bqgjd', ps.astype(vs.dtype), vs)
        kwb = lax.dynamic_slice_in_dim(kw, s0, Q_BLOCK + WINDOW, axis=1)
        vwb = lax.dynamic_slice_in_dim(vw, s0, Q_BLOCK + WINDOW, axis=1)
        kp = s0 - WINDOW + jnp.arange(Q_BLOCK + WINDOW)
        wmask = ((kp[None, :] >= 0) & (kp[None, :] <= t[:, None])
                 & (kp[None, :] > t[:, None] - WINDOW))
        sw = jnp.einsum('bqgjd,bkgd->bgjqk', qb, kwb) * scale
        pw = masked_softmax(sw, wmask)
        o_win = jnp.einsum('bgjqk,bkgd->bqgjd', pw.astype(vwb.dtype), vwb)
        o = gb[..., 0:1] * o_cmp + gb[..., 1:2] * o_slc + gb[..., 2:3] * o_win
        return o.reshape(B, Q_BLOCK, NSA_HEADS * dk)

    o = lax.map(block, jnp.arange(S // Q_BLOCK))
    return o.transpose(1, 0, 2, 3).reshape(B, S, NSA_HEADS * dk)


def gated_conv_ffn(h, w_up, conv_w, conv_b, w_down):
    a, b = jnp.split(h @ w_up, 2, axis=-1)
    a = causal_dwconv(a, conv_w, conv_b)
    return (jax.nn.gelu(a) * b) @ w_down


def setup_inputs(seed: int = 0) -> dict:
    key = jax.random.key(seed)
    keys = jax.random.split(key, 24)

    def dense(k, shape, fan_in):
        return jax.random.normal(k, shape, jnp.float32) * fan_in ** -0.5

    def gain(k, n):
        return 1.0 + 0.05 * jax.random.normal(k, (DEPTH, n), jnp.float32)

    x = jax.random.normal(keys[0], (BATCH, SEQ, D_MODEL), jnp.float32)
    positions = jnp.broadcast_to(jnp.arange(SEQ, dtype=jnp.int32)[None, :], (BATCH, SEQ))
    return {
        'x': x,
        'positions': positions,
        'norm_mix_pre': gain(keys[1], D_MODEL),
        'norm_mix_post': gain(keys[2], D_MODEL),
        'w_in': dense(keys[3], (DEPTH, D_MODEL, N_IN), D_MODEL),
        'conv_w': dense(keys[4], (DEPTH, CONV_WIDTH, D_CONV), CONV_WIDTH),
        'mla_q_norm': gain(keys[5], MLA_Q_LORA),
        'mla_w_uq': dense(keys[6], (DEPTH, MLA_Q_LORA, MLA_HEADS * (MLA_NOPE + MLA_ROPE)), MLA_Q_LORA),
        'mla_kv_norm': gain(keys[7], MLA_KV_LORA),
        'mla_w_ukv': dense(keys[8], (DEPTH, MLA_KV_LORA, MLA_HEADS * (MLA_NOPE + MLA_V)), MLA_KV_LORA),
        'nsa_cmp_pos_k': 0.1 * jax.random.normal(keys[9], (DEPTH, CMP_LEN, NSA_DIM), jnp.float32),
        'nsa_cmp_pos_v': 0.1 * jax.random.normal(keys[10], (DEPTH, CMP_LEN, NSA_DIM), jnp.float32),
        'nsa_cmp_w_k': dense(keys[11], (DEPTH, CMP_LEN * NSA_DIM, NSA_DIM), CMP_LEN * NSA_DIM),
        'nsa_cmp_w_v': dense(keys[12], (DEPTH, CMP_LEN * NSA_DIM, NSA_DIM), CMP_LEN * NSA_DIM),
        'w_branch_conv': dense(keys[13], (DEPTH, D_CONV, D_MODEL), D_CONV),
        'w_branch_mla': dense(keys[14], (DEPTH, MLA_HEADS * MLA_V, D_MODEL), MLA_HEADS * MLA_V),
        'w_branch_nsa': dense(keys[15], (DEPTH, NSA_HEADS * NSA_DIM, D_MODEL), NSA_HEADS * NSA_DIM),
        'w_out': dense(keys[16], (DEPTH, D_MODEL, D_MODEL), D_MODEL),
        'norm_ffn_pre': gain(keys[17], D_MODEL),
        'norm_ffn_post': gain(keys[18], D_MODEL),
        'ffn_w_up': dense(keys[19], (DEPTH, D_MODEL, 2 * D_FF), D_MODEL),
        'ffn_conv_w': dense(keys[20], (DEPTH, CONV_WIDTH, D_FF), CONV_WIDTH),
        'ffn_conv_b': 0.01 * jax.random.normal(keys[21], (DEPTH, D_FF), jnp.float32),
        'ffn_w_down': dense(keys[22], (DEPTH, D_FF, D_MODEL), D_FF),
    }


def reference(x, positions, norm_mix_pre, norm_mix_post, w_in, conv_w, mla_q_norm, mla_w_uq,
              mla_kv_norm, mla_w_ukv, nsa_cmp_pos_k, nsa_cmp_pos_v, nsa_cmp_w_k, nsa_cmp_w_v,
              w_branch_conv, w_branch_mla, w_branch_nsa, w_out, norm_ffn_pre, norm_ffn_post,
              ffn_w_up, ffn_conv_w, ffn_conv_b, ffn_w_down):
    for l in range(DEPTH):
        h = rms_norm(x, norm_mix_pre[l])
        (g_conv, g_mla, g_nsa, c_b, c_c, c_x, mla_cq, mla_ckv, mla_kr,
         nsa_q, nsa_kc, nsa_vc, nsa_ks, nsa_vs, nsa_kw, nsa_vw, nsa_g) = jnp.split(
            h @ w_in[l], SPLIT_POINTS, axis=-1)
        y_conv = short_conv_mixer(c_b, c_c, c_x, conv_w[l])
        y_mla = mla_mixer(mla_cq, mla_ckv, mla_kr, positions, mla_q_norm[l], mla_w_uq[l],
                          mla_kv_norm[l], mla_w_ukv[l])
        y_nsa = nsa_mixer(nsa_q, nsa_kc, nsa_vc, nsa_ks, nsa_vs, nsa_kw, nsa_vw, nsa_g, positions,
                          nsa_cmp_pos_k[l], nsa_cmp_pos_v[l], nsa_cmp_w_k[l], nsa_cmp_w_v[l])
        merged = (jax.nn.sigmoid(g_conv) * (y_conv @ w_branch_conv[l])
                  + jax.nn.sigmoid(g_mla) * (y_mla @ w_branch_mla[l])
                  + jax.nn.sigmoid(g_nsa) * (y_nsa @ w_branch_nsa[l]))
        x = x + rms_norm(merged @ w_out[l], norm_mix_post[l])
        h = rms_norm(x, norm_ffn_pre[l])
        x = x + rms_norm(gated_conv_ffn(h, ffn_w_up[l], ffn_conv_w[l], ffn_conv_b[l], ffn_w_down[l]),
                         norm_ffn_post[l])
    return x
```

```cpp
#include <hip/hip_runtime.h>
#include <hip/hip_cooperative_groups.h>
#include <cstdio>
namespace cg = cooperative_groups;

#define DI __device__ __forceinline__
typedef unsigned short u16;
typedef short bf16x8 __attribute__((ext_vector_type(8)));
typedef float f32x16 __attribute__((ext_vector_type(16)));
typedef __bf16 bf2_t __attribute__((ext_vector_type(2)));
typedef float f2_t __attribute__((ext_vector_type(2)));
typedef unsigned u32x4 __attribute__((ext_vector_type(4)));
typedef unsigned u32x2 __attribute__((ext_vector_type(2)));
typedef float f32x4 __attribute__((ext_vector_type(4)));

constexpr int NB = 4, S = 8192, T = NB * S;
constexpr int N1 = 3512;
constexpr int DFF = 2816;
constexpr size_t MiB = 1ull << 20;

constexpr size_t W_IN = 0;
constexpr size_t W_UQ = W_IN + 6656ull * 1024;
constexpr size_t W_UKV = W_UQ + 768ull * 384;
constexpr size_t W_CK = W_UKV + 1024ull * 256;
constexpr size_t W_CV = W_CK + 64ull * 2048;
constexpr size_t W_BC = W_CV + 64ull * 2048;
constexpr size_t W_BM = W_BC + 1024ull * 512;
constexpr size_t W_BN = W_BM + 1024ull * 512;
constexpr size_t W_OUT = W_BN + 1024ull * 512;
constexpr size_t W_UP = W_OUT + 1024ull * 1024;
constexpr size_t W_DOWN = W_UP + 5632ull * 1024;
constexpr size_t W_LAYER = W_DOWN + 1024ull * 2816;

constexpr size_t OFF_BIAS = 73 * MiB;
constexpr size_t OFF_BAR = 73 * MiB + 65536;
constexpr size_t OFF_H = 74 * MiB;
constexpr size_t OFF_P1A = 138 * MiB;
constexpr size_t OFF_P1B = 234 * MiB;
constexpr size_t OFF_YCONV = 276 * MiB;
constexpr size_t OFF_QN = 308 * MiB;
constexpr size_t OFF_KCMP = 340 * MiB;
constexpr size_t OFF_VCMP = 348 * MiB;
constexpr size_t OFF_KSLC = 356 * MiB;
constexpr size_t OFF_KWIN = 364 * MiB;
constexpr size_t OFF_VST = 372 * MiB;
constexpr size_t OFF_VWT = 380 * MiB;
constexpr size_t OFF_G = 388 * MiB;
constexpr size_t OFF_KC = 391 * MiB;
constexpr size_t OFF_VCT = 391 * MiB + 512 * 1024;
constexpr size_t OFF_SEL = 392 * MiB;
constexpr size_t OFF_KMLA = 394 * MiB;
constexpr size_t OFF_YMLA = 442 * MiB;
constexpr size_t OFF_YNSA = 474 * MiB;
constexpr size_t OFF_QMLA = 138 * MiB;
constexpr size_t OFF_VTMLA = 186 * MiB;
constexpr size_t OFF_MERGED = 138 * MiB;
constexpr size_t OFF_O = 202 * MiB;
constexpr size_t OFF_U = 138 * MiB;

struct Params {
  const void* in[24];
  float* out;
  char* ws;
};

__device__ const double INVF[16] = {
    1.0, 0.44036660267178046, 0.19392274474868576, 0.08539710028576561, 0.03760603093086393, 0.016560440080994446,
    0.007292664737217109, 0.003211445994752591, 0.001414213562373095, 0.000622772421914596, 0.0002742481756762073,
    0.00012076973741146504, 5.318295896944988e-05, 2.341999896140934e-05, 1.031338537721246e-05, 4.5416704806078695e-06};

DI u32x4 mk_u4(unsigned a, unsigned b, unsigned c, unsigned d) { u32x4 v = {a, b, c, d}; return v; }
DI f32x4 mk_f4(float a, float b, float c, float d) { f32x4 v = {a, b, c, d}; return v; }
DI char* wsp(const Params& p) { size_t z = 0; asm volatile("" : "+s"(z)); return p.ws + z; }
DI const void* inp(const Params& p, int i) { size_t z = 0; asm volatile("" : "+s"(z)); return (const char*)p.in[i] + z; }
DI int otid() { int t = __builtin_amdgcn_workitem_id_x(); asm volatile("" : "+v"(t)); return t; }
DI unsigned pack2(float a, float b) {
  f2_t v = {a, b};
  bf2_t r = __builtin_convertvector(v, bf2_t);
  return __builtin_bit_cast(unsigned, r);
}
DI u16 f2bf(float a) { return (u16)(pack2(a, 0.f) & 0xffffu); }
DI float bf2f(u16 v) { return __uint_as_float(((unsigned)v) << 16); }
DI float bflo(unsigned v) { return __uint_as_float(v << 16); }
DI float bfhi(unsigned v) { return __uint_as_float(v & 0xffff0000u); }
DI float wave_sum(float v) {
#pragma unroll
  for (int o = 32; o > 0; o >>= 1) v += __shfl_xor(v, o, 64);
  return v;
}
DI int crow(int i, int hh) { return (i & 3) + 8 * (i >> 2) + 4 * hh; }
DI int permq(int s) {
  int qd = (s >> 2) & 3;
  int nq = ((qd & 1) << 1) | (qd >> 1);
  return (s & ~15) | (nq << 2);
}
DI void sincos_pos(int pos, double invf, float& c, float& s) {
  double rev = (double)pos * invf * 0.15915494309189535;
  rev -= floor(rev);
  float rf = (float)rev;
  s = __builtin_amdgcn_sinf(rf);
  c = __builtin_amdgcn_cosf(rf);
}
DI float sigmoidf_(float x) { return 1.f / (1.f + __expf(-x)); }
DI f32x16 zero16() {
  f32x16 z;
#pragma unroll
  for (int i = 0; i < 16; ++i) z[i] = 0.f;
  return z;
}
#define MFMA(a, b, c) __builtin_amdgcn_mfma_f32_32x32x16_bf16((a), (b), (c), 0, 0, 0)

#define WAIT_V0() asm volatile("s_waitcnt vmcnt(0)" ::: "memory")
template <int WN>
DI int gemm_acc_chain(const u16* __restrict__ A, int lda, const u16* __restrict__ Bt, int ldb, int K, f32x16 (&acc)[4][WN], char* lds, int pre,
                      const u16* nA, int nlda, const u16* nBt, int nldb) {
  constexpr int STAGE = 65536;
  constexpr int NBI = 2 * WN;
  const int tid = otid(), lane = tid & 63, w = tid >> 6, r = lane & 31, hh = lane >> 5, wm = w >> 2, wn = w & 3;
  const int srow = 8 * w + (lane >> 3);
  const int sc = (lane & 7) ^ ((srow >> 1) & 7);
  const int nk = K >> 6;
  auto stage = [&](const u16* A_, int lda_, const u16* Bt_, int ldb_, int buf, int k0) {
    char* sa = lds + buf * STAGE + w * 1024;
    const unsigned aoff = (unsigned)(srow * lda_ + sc * 8) * 2u;
    const unsigned boff = (unsigned)(srow * ldb_ + sc * 8) * 2u;
#pragma unroll
    for (int i = 0; i < 4; ++i)
      __builtin_amdgcn_global_load_lds((const unsigned*)((const char*)A_ + (aoff + (unsigned)((64 * i) * lda_ + k0) * 2u)), (unsigned*)(sa + i * 8192), 16, 0, 0);
#pragma unroll
    for (int i = 0; i < NBI; ++i)
      __builtin_amdgcn_global_load_lds((const unsigned*)((const char*)Bt_ + (boff + (unsigned)((64 * i) * ldb_ + k0) * 2u)), (unsigned*)(sa + 32768 + i * 8192), 16, 0, 0);
  };
  const int base = pre >= 0 ? pre : 0;
  if (pre < 0) {
    stage(A, lda, Bt, ldb, 0, 0);
    WAIT_V0();
    __syncthreads();
  }
  for (int kt = 0; kt < nk; ++kt) {
    const int buf = (base + kt) & 1;
    const char* st = lds + buf * STAGE;
    if (kt + 1 < nk) stage(A, lda, Bt, ldb, buf ^ 1, (kt + 1) << 6);
    else if (nA) stage(nA, nlda, nBt, nldb, buf ^ 1, 0);
#pragma unroll
    for (int s = 0; s < 4; ++s) {
      const int chunk = 2 * s + hh;
      bf16x8 a[4], b[WN];
#pragma unroll
      for (int mi = 0; mi < 4; ++mi) {
        const int row = 128 * wm + 32 * mi + r;
        a[mi] = *(const bf16x8*)(st + row * 128 + ((chunk ^ ((row >> 1) & 7)) << 4));
      }
#pragma unroll
      for (int ni = 0; ni < WN; ++ni) {
        const int row = 32 * WN * wn + 32 * ni + r;
        b[ni] = *(const bf16x8*)(st + 32768 + row * 128 + ((chunk ^ ((row >> 1) & 7)) << 4));
      }
#pragma unroll
      for (int mi = 0; mi < 4; ++mi)
#pragma unroll
        for (int ni = 0; ni < WN; ++ni) acc[mi][ni] = MFMA(a[mi], b[ni], acc[mi][ni]);
    }
    WAIT_V0();
    __syncthreads();
  }
  return (base + nk) & 1;
}
template <int WN>
DI void gemm_acc(const u16* __restrict__ A, int lda, const u16* __restrict__ Bt, int ldb, int K, f32x16 (&acc)[4][WN], char* lds) {
  (void)gemm_acc_chain<WN>(A, lda, Bt, ldb, K, acc, lds, -1, nullptr, 0, nullptr, 0);
}


typedef float f32x4m __attribute__((ext_vector_type(4)));
DI int g8_lds_byte(int r, int c) {
  const int st = (r >> 4) * 2 + (c >> 5), rr = r & 15, cc = c & 31, ob = rr * 64 + cc * 2;
  return st * 1024 + (ob ^ (((ob >> 9) & 1) << 5));
}
DI void gemm8_prologue(const u16* __restrict__ A, int lda, const u16* __restrict__ Bt, int ldb, char* lds) {
  constexpr int HTB = 16384;
  const int tid = otid();
  char* const sbase = lds + tid * 16;
#pragma unroll
  for (int h = 0; h < 2; ++h) {
#pragma unroll
    for (int i = 0; i < 2; ++i) {
      const int b = tid * 16 + i * 8192;
      const int st = b >> 10, sb = b & 1023, swz = sb ^ (((sb >> 9) & 1) << 5);
      const int R = (st >> 1) * 16 + (swz >> 6) + h * 128, C = (st & 1) * 32 + ((swz & 63) >> 1);
      __builtin_amdgcn_global_load_lds((const unsigned*)((const char*)Bt + (unsigned)(R * ldb + C) * 2u), (unsigned*)(sbase + (4 + h) * HTB + i * 8192), 16, 0, 0);
    }
#pragma unroll
    for (int i = 0; i < 2; ++i) {
      const int b = tid * 16 + i * 8192;
      const int st = b >> 10, sb = b & 1023, swz = sb ^ (((sb >> 9) & 1) << 5);
      const int R = (st >> 1) * 16 + (swz >> 6) + h * 128, C = (st & 1) * 32 + ((swz & 63) >> 1);
      __builtin_amdgcn_global_load_lds((const unsigned*)((const char*)A + (unsigned)(R * lda + C) * 2u), (unsigned*)(sbase + h * HTB + i * 8192), 16, 0, 0);
    }
  }
}
DI void gemm8_acc(const u16* __restrict__ A, int lda, const u16* __restrict__ Bt, int ldb, int K, f32x4m (&acc)[2][2][4][2], char* lds, bool pre = false) {
  constexpr int HTB = 16384;
  const int tid = otid(), wid = tid >> 6, lane = tid & 63, wr = wid >> 2, wc = wid & 3, fr = lane & 15, fq = lane >> 4;
  unsigned oa[2], ob_[2];
#pragma unroll
  for (int i = 0; i < 2; ++i) {
    const int b = tid * 16 + i * 8192;
    const int st = b >> 10, sb = b & 1023, swz = sb ^ (((sb >> 9) & 1) << 5);
    const int R = (st >> 1) * 16 + (swz >> 6), C = (st & 1) * 32 + ((swz & 63) >> 1);
    oa[i] = (unsigned)(R * lda + C) * 2u;
    ob_[i] = (unsigned)(R * ldb + C) * 2u;
  }
  char* const sbase = lds + tid * 16;
#define G8_SA(b, h) (lds + ((b) * 2 + (h)) * HTB)
#define G8_SB(b, h) (lds + (4 + (b) * 2 + (h)) * HTB)
#define G8_STAGE_A(b, h, kt) do { _Pragma("unroll") for (int _i = 0; _i < 2; ++_i) \
    __builtin_amdgcn_global_load_lds((const unsigned*)((const char*)A + (oa[_i] + (unsigned)((h) * 128 * lda + (kt) * 64) * 2u)), \
                                     (unsigned*)(sbase + ((b) * 2 + (h)) * HTB + _i * 8192), 16, 0, 0); } while (0)
#define G8_STAGE_B(b, h, kt) do { _Pragma("unroll") for (int _i = 0; _i < 2; ++_i) \
    __builtin_amdgcn_global_load_lds((const unsigned*)((const char*)Bt + (ob_[_i] + (unsigned)((h) * 128 * ldb + (kt) * 64) * 2u)), \
                                     (unsigned*)(sbase + (4 + (b) * 2 + (h)) * HTB + _i * 8192), 16, 0, 0); } while (0)
#define G8_LDA(dst, b, h) do { _Pragma("unroll") for (int m = 0; m < 4; ++m) _Pragma("unroll") for (int k = 0; k < 2; ++k) \
    dst[m][k] = *(const bf16x8*)(G8_SA(b, h) + g8_lds_byte(wr * 64 + m * 16 + fr, k * 32 + fq * 8)); } while (0)
#define G8_LDB(dst, b, h) do { _Pragma("unroll") for (int n = 0; n < 2; ++n) _Pragma("unroll") for (int k = 0; k < 2; ++k) \
    dst[n][k] = *(const bf16x8*)(G8_SB(b, h) + g8_lds_byte(wc * 32 + n * 16 + fr, k * 32 + fq * 8)); } while (0)
#define G8_MMA(ai, bj, At_, Bt_) do { __builtin_amdgcn_s_setprio(1); \
    _Pragma("unroll") for (int m = 0; m < 4; ++m) _Pragma("unroll") for (int n = 0; n < 2; ++n) _Pragma("unroll") for (int k = 0; k < 2; ++k) \
      acc[ai][bj][m][n] = __builtin_amdgcn_mfma_f32_16x16x32_bf16(At_[m][k], Bt_[n][k], acc[ai][bj][m][n], 0, 0, 0); \
    __builtin_amdgcn_s_setprio(0); } while (0)
#define G8_WV(n) asm volatile("s_waitcnt vmcnt(" #n ")" ::: "memory")
#define G8_WL(n) asm volatile("s_waitcnt lgkmcnt(" #n ")" ::: "memory")
#define G8_BAR __builtin_amdgcn_s_barrier()
#define G8_SCHED __builtin_amdgcn_sched_barrier(0)
  bf16x8 At[4][2], B0[2][2], B1[2][2];
  const int nt = K >> 6;
  if (!pre) { G8_STAGE_B(0, 0, 0); G8_STAGE_A(0, 0, 0); G8_STAGE_B(0, 1, 0); G8_STAGE_A(0, 1, 0); }
  if (wr == 1) G8_BAR;
  G8_WV(4); G8_BAR;
  G8_STAGE_B(1, 0, 1); G8_STAGE_A(1, 0, 1); G8_STAGE_B(1, 1, 1);
  G8_WV(6); G8_BAR;
  for (int t = 0; t < nt - 2; t += 2) {
    G8_LDB(B0, 0, 0); G8_SCHED; G8_LDA(At, 0, 0); G8_STAGE_A(1, 1, t + 1);
    G8_WL(8); G8_BAR; G8_WL(0); G8_MMA(0, 0, At, B0); G8_BAR; G8_SCHED;
    G8_LDB(B1, 0, 1); G8_STAGE_B(0, 0, t + 2);
    G8_BAR; G8_WL(0); G8_MMA(0, 1, At, B1); G8_BAR;
    G8_LDA(At, 0, 1); G8_STAGE_A(0, 0, t + 2);
    G8_BAR; G8_WL(0); G8_MMA(1, 0, At, B0); G8_BAR; G8_SCHED;
    G8_STAGE_B(0, 1, t + 2);
    G8_WV(6); G8_BAR; G8_MMA(1, 1, At, B1); G8_BAR;
    G8_LDB(B0, 1, 0); G8_SCHED; G8_LDA(At, 1, 0); G8_STAGE_A(0, 1, t + 2);
    G8_WL(8); G8_BAR; G8_WL(0); G8_MMA(0, 0, At, B0); G8_BAR; G8_SCHED;
    G8_LDB(B1, 1, 1); G8_STAGE_B(1, 0, t + 3);
    G8_BAR; G8_WL(0); G8_MMA(0, 1, At, B1); G8_BAR;
    G8_LDA(At, 1, 1); G8_STAGE_A(1, 0, t + 3);
    G8_BAR; G8_WL(0); G8_MMA(1, 0, At, B0); G8_BAR; G8_SCHED;
    G8_STAGE_B(1, 1, t + 3);
    G8_WV(6); G8_BAR; G8_MMA(1, 1, At, B1); G8_BAR;
  }
  {
    G8_LDB(B0, 0, 0); G8_LDA(At, 0, 0); G8_STAGE_A(1, 1, nt - 1);
    G8_BAR; G8_WL(0); G8_MMA(0, 0, At, B0); G8_BAR;
    G8_LDB(B1, 0, 1); G8_BAR; G8_WL(0); G8_MMA(0, 1, At, B1); G8_BAR;
    G8_LDA(At, 0, 1); G8_WV(4); G8_BAR; G8_WL(0); G8_MMA(1, 0, At, B0); G8_MMA(1, 1, At, B1); G8_BAR;
  }
  {
    G8_LDB(B0, 1, 0); G8_LDA(At, 1, 0); G8_WV(2); G8_BAR; G8_WL(0); G8_MMA(0, 0, At, B0); G8_BAR;
    G8_LDB(B1, 1, 1); G8_WV(0); G8_BAR; G8_WL(0); G8_MMA(0, 1, At, B1); G8_BAR;
    G8_LDA(At, 1, 1); G8_BAR; G8_WL(0); G8_MMA(1, 0, At, B0); G8_MMA(1, 1, At, B1); G8_BAR;
  }
  if (wr == 0) G8_BAR;
}
template <class F>
DI void epi8_apply(f32x4m (&acc)[2][2][4][2], int m0, int n0, F f) {
  const int tid = otid(), wid = tid >> 6, lane = tid & 63, wr = wid >> 2, wc = wid & 3, fr = lane & 15, fq = lane >> 4;
#pragma unroll
  for (int ai = 0; ai < 2; ++ai)
#pragma unroll
    for (int bj = 0; bj < 2; ++bj)
#pragma unroll
      for (int m = 0; m < 4; ++m)
#pragma unroll
        for (int n = 0; n < 2; ++n) {
          const f32x4m v = acc[ai][bj][m][n];
          f(m0 + ai * 128 + wr * 64 + m * 16 + fq * 4, n0 + bj * 128 + wc * 32 + n * 16 + fr, v[0], v[1], v[2], v[3]);
        }
}
DI void zero_acc8(f32x4m (&acc)[2][2][4][2]) {
#pragma unroll
  for (int ai = 0; ai < 2; ++ai)
#pragma unroll
    for (int bj = 0; bj < 2; ++bj)
#pragma unroll
      for (int m = 0; m < 4; ++m)
#pragma unroll
        for (int n = 0; n < 2; ++n) { f32x4m z = {0.f, 0.f, 0.f, 0.f}; acc[ai][bj][m][n] = z; }
}

template <int WN>
DI void zero_acc(f32x16 (&acc)[4][WN]) {
#pragma unroll
  for (int mi = 0; mi < 4; ++mi)
#pragma unroll
    for (int ni = 0; ni < WN; ++ni) acc[mi][ni] = zero16();
}

template <int WN, class F>
DI void epi_apply(f32x16 (&acc)[4][WN], int m0, int n0, F f) {
  const int tid = otid(), lane = tid & 63, w = tid >> 6, r = lane & 31, hh = lane >> 5, wm = w >> 2, wn = w & 3;
#pragma unroll
  for (int mi = 0; mi < 4; ++mi)
#pragma unroll
    for (int ni = 0; ni < WN; ++ni)
#pragma unroll
      for (int g4 = 0; g4 < 4; ++g4) {
        const int m = m0 + 128 * wm + 32 * mi + 8 * g4 + 4 * hh;
        const int n = n0 + 32 * WN * wn + 32 * ni + r;
        f(m, n, acc[mi][ni][4 * g4], acc[mi][ni][4 * g4 + 1], acc[mi][ni][4 * g4 + 2], acc[mi][ni][4 * g4 + 3]);
      }
}

DI void store_rows(u16* dst, size_t ld, int m, int n, float v0, float v1, float v2, float v3) {
  u16* q = dst + (size_t)m * ld + n;
  q[0] = f2bf(v0);
  q[ld] = f2bf(v1);
  q[2 * ld] = f2bf(v2);
  q[3 * ld] = f2bf(v3);
}
DI void store_quad(u16* dst, float v0, float v1, float v2, float v3) {
  u32x2 u;
  u.x = pack2(v0, v1);
  u.y = pack2(v2, v3);
  *(u32x2*)dst = u;
}

template <int R>
DI void rowpass(const float* xs, float* xd, const u16* o, const float* gpost, const float* gnext, u16* hd, int row0, int stride, int lane) {
  float xv[R][16];
  float ov[R][16];
#pragma unroll
  for (int k = 0; k < R; ++k) {
    const float* xr = xs + (size_t)(row0 + k * stride) * 1024;
#pragma unroll
    for (int i = 0; i < 4; ++i) {
      f32x4 v = __builtin_nontemporal_load((const f32x4*)(xr + lane * 4 + 256 * i));
      xv[k][4 * i] = v.x; xv[k][4 * i + 1] = v.y; xv[k][4 * i + 2] = v.z; xv[k][4 * i + 3] = v.w;
    }
  }
  if (o) {
#pragma unroll
    for (int k = 0; k < R; ++k) {
      const u16* orow = o + (size_t)(row0 + k * stride) * 1024;
#pragma unroll
      for (int i = 0; i < 4; ++i) {
        u32x2 u = __builtin_nontemporal_load((const u32x2*)(orow + lane * 4 + 256 * i));
        ov[k][4 * i] = bflo(u.x); ov[k][4 * i + 1] = bfhi(u.x); ov[k][4 * i + 2] = bflo(u.y); ov[k][4 * i + 3] = bfhi(u.y);
      }
    }
    float gp[16];
#pragma unroll
    for (int i = 0; i < 4; ++i) {
      f32x4 g = *(const f32x4*)(gpost + lane * 4 + 256 * i);
      gp[4 * i] = g.x; gp[4 * i + 1] = g.y; gp[4 * i + 2] = g.z; gp[4 * i + 3] = g.w;
    }
    float ss[R];
#pragma unroll
    for (int k = 0; k < R; ++k) {
      ss[k] = 0.f;
#pragma unroll
      for (int i = 0; i < 16; ++i) ss[k] += ov[k][i] * ov[k][i];
    }
#pragma unroll
    for (int off = 32; off > 0; off >>= 1)
#pragma unroll
      for (int k = 0; k < R; ++k) ss[k] += __shfl_xor(ss[k], off, 64);
#pragma unroll
    for (int k = 0; k < R; ++k) {
      const float rs = rsqrtf(ss[k] * (1.f / 1024.f) + 1e-6f);
#pragma unroll
      for (int i = 0; i < 16; ++i) xv[k][i] += ov[k][i] * rs * gp[i];
      float* xw = xd + (size_t)(row0 + k * stride) * 1024;
#pragma unroll
      for (int i = 0; i < 4; ++i) __builtin_nontemporal_store(mk_f4(xv[k][4 * i], xv[k][4 * i + 1], xv[k][4 * i + 2], xv[k][4 * i + 3]), (f32x4*)(xw + lane * 4 + 256 * i));
    }
  }
  if (gnext) {
    float gn[16];
#pragma unroll
    for (int i = 0; i < 4; ++i) {
      f32x4 g = *(const f32x4*)(gnext + lane * 4 + 256 * i);
      gn[4 * i] = g.x; gn[4 * i + 1] = g.y; gn[4 * i + 2] = g.z; gn[4 * i + 3] = g.w;
    }
    float ss[R];
#pragma unroll
    for (int k = 0; k < R; ++k) {
      ss[k] = 0.f;
#pragma unroll
      for (int i = 0; i < 16; ++i) ss[k] += xv[k][i] * xv[k][i];
    }
#pragma unroll
    for (int off = 32; off > 0; off >>= 1)
#pragma unroll
      for (int k = 0; k < R; ++k) ss[k] += __shfl_xor(ss[k], off, 64);
#pragma unroll
    for (int k = 0; k < R; ++k) {
      const float rs = rsqrtf(ss[k] * (1.f / 1024.f) + 1e-6f);
      u16* hw = hd + (size_t)(row0 + k * stride) * 1024;
#pragma unroll
      for (int i = 0; i < 4; ++i) {
        u32x2 u;
        u.x = pack2(xv[k][4 * i] * rs * gn[4 * i], xv[k][4 * i + 1] * rs * gn[4 * i + 1]);
        u.y = pack2(xv[k][4 * i + 2] * rs * gn[4 * i + 2], xv[k][4 * i + 3] * rs * gn[4 * i + 3]);
        *(u32x2*)(hw + lane * 4 + 256 * i) = u;
      }
    }
  }
}
DI void rowpass_all(const float* xs, float* xd, const u16* o, const float* gpost, const float* gnext, u16* hd) {
  const int lane = otid() & 63, gw = blockIdx.x * 8 + (otid() >> 6), nw = gridDim.x * 8;
  int row = gw;
  for (; row + 3 * nw < T; row += 4 * nw) rowpass<4>(xs, xd, o, gpost, gnext, hd, row, nw, lane);
  for (; row < T; row += nw) rowpass<1>(xs, xd, o, gpost, gnext, hd, row, nw, lane);
}

DI void transpose_job(const float* __restrict__ src, u16* __restrict__ dst, int K, int N, int Npad, char* lds) {
  float* sm = (float*)lds;
  const int tid = otid();
  const int ktiles = K >> 6;
  const int ntiles = (Npad >> 6) * ktiles;
  for (int tile = blockIdx.x; tile < ntiles; tile += gridDim.x) {
    const int kt = tile % ktiles, nt = tile / ktiles;
    const int k0 = kt << 6, n0 = nt << 6;
    const int nl = tid & 63;
#pragma unroll
    for (int i = 0; i < 8; ++i) {
      const int kk = (tid >> 6) + 8 * i;
      const int n = n0 + nl;
      float v = (n < N) ? __builtin_nontemporal_load(src + (size_t)(k0 + kk) * N + n) : 0.f;
      sm[kk * 65 + nl] = v;
    }
    __syncthreads();
    const int nr = tid >> 3, seg = tid & 7;
    unsigned u[4];
#pragma unroll
    for (int j = 0; j < 4; ++j) u[j] = pack2(sm[(seg * 8 + 2 * j) * 65 + nr], sm[(seg * 8 + 2 * j + 1) * 65 + nr]);
    u16* d = dst + (size_t)(n0 + nr) * K + k0 + seg * 8;
    *(u32x4*)d = mk_u4(u[0], u[1], u[2], u[3]);
    __syncthreads();
  }
}

DI void phase0(const Params& p, char* lds) {
  u16* wbase = (u16*)wsp(p);
  for (int l = 0; l < 2; ++l) {
    u16* wl = wbase + (size_t)l * W_LAYER;
    transpose_job((const float*)inp(p, 4) + (size_t)l * 1024 * 6584, wl + W_IN, 1024, 6584, 6656, lds);
    transpose_job((const float*)inp(p, 7) + (size_t)l * 384 * 768, wl + W_UQ, 384, 768, 768, lds);
    transpose_job((const float*)inp(p, 9) + (size_t)l * 256 * 1024, wl + W_UKV, 256, 1024, 1024, lds);
    transpose_job((const float*)inp(p, 12) + (size_t)l * 2048 * 64, wl + W_CK, 2048, 64, 64, lds);
    transpose_job((const float*)inp(p, 13) + (size_t)l * 2048 * 64, wl + W_CV, 2048, 64, 64, lds);
    transpose_job((const float*)inp(p, 14) + (size_t)l * 512 * 1024, wl + W_BC, 512, 1024, 1024, lds);
    transpose_job((const float*)inp(p, 15) + (size_t)l * 512 * 1024, wl + W_BM, 512, 1024, 1024, lds);
    transpose_job((const float*)inp(p, 16) + (size_t)l * 512 * 1024, wl + W_BN, 512, 1024, 1024, lds);
    transpose_job((const float*)inp(p, 17) + (size_t)l * 1024 * 1024, wl + W_OUT, 1024, 1024, 1024, lds);
    transpose_job((const float*)inp(p, 20) + (size_t)l * 1024 * 5632, wl + W_UP, 1024, 5632, 5632, lds);
    transpose_job((const float*)inp(p, 23) + (size_t)l * 2816 * 1024, wl + W_DOWN, 2816, 1024, 1024, lds);
  }
  const int lane = otid() & 63, gw = blockIdx.x * 8 + (otid() >> 6), nw = gridDim.x * 8;
  float* bias = (float*)(wsp(p) + OFF_BIAS);
  for (int oi = gw; oi < 256; oi += nw) {
    const int l = oi >> 7, kv = (oi >> 6) & 1, e = oi & 63;
    const float* pos = (const float*)p.in[kv ? 11 : 10] + (size_t)l * 2048;
    const float* wt = (const float*)p.in[kv ? 13 : 12] + (size_t)l * 2048 * 64;
    float s = 0.f;
    for (int idx = lane; idx < 2048; idx += 64) s += pos[idx] * wt[(size_t)idx * 64 + e];
    s = wave_sum(s);
    if (lane == 0) bias[oi] = s;
  }
  rowpass_all((const float*)inp(p, 0), nullptr, nullptr, nullptr, (const float*)inp(p, 2), (u16*)(wsp(p) + OFF_H));
}


DI bool tile_mn(int j, int NT, int total, int& mt, int& nt) {
  const int i = blockIdx.x;
  const int lin = j * gridDim.x + (i & 7) * (gridDim.x >> 3) + (i >> 3);
  if (lin >= total) return false;
  mt = 4 * (lin / (4 * NT)) + (lin & 3);
  nt = (lin >> 2) % NT;
  return true;
}

DI void phaseA(const Params& p, int l, char* lds) {
  const u16* h = (const u16*)(wsp(p) + OFF_H);
  const u16* wt = (const u16*)wsp(p) + (size_t)l * W_LAYER + W_IN + (size_t)3072 * 1024;
  char* ws = wsp(p);
  bool pre = false;
  for (int j = 0; j * (int)gridDim.x < 128 * 14; ++j) {
    int mt, nt;
    if (!tile_mn(j, 14, 128 * 14, mt, nt)) continue;
    const int m0 = mt * 256, n0 = nt * 256;
    int mt2 = 0, nt2 = 0;
    const bool has_next = ((j + 1) * (int)gridDim.x < 128 * 14) && tile_mn(j + 1, 14, 128 * 14, mt2, nt2);
    f32x4m acc[2][2][4][2];
    zero_acc8(acc);
    gemm8_acc(h + (size_t)m0 * 1024, 1024, wt + (size_t)n0 * 1024, 1024, 1024, acc, lds, pre);
    if (has_next) gemm8_prologue(h + (size_t)(mt2 * 256) * 1024, 1024, wt + (size_t)(nt2 * 256) * 1024, 1024, lds);
    pre = has_next;
    epi8_apply(acc, m0, n0, [&](int m, int n, float v0, float v1, float v2, float v3) {
      const int b = m >> 13, s = m & (S - 1);
      if (n < 1536) {
        store_rows((u16*)(ws + OFF_P1A), 1536, m, n, v0, v1, v2, v3);
      } else if (n < 2208) {
        store_rows((u16*)(ws + OFF_P1B), 672, m, n - 1536, v0, v1, v2, v3);
      } else if (n < 2720) {
        const int c = n - 2208, hd = c >> 6, d = c & 63;
        store_rows((u16*)(ws + OFF_QN) + (size_t)(b * 8 + hd) * S * 64, 64, s, d, v0, v1, v2, v3);
      } else if (n < 3488) {
        const int seg = (n - 2720) >> 7;
        const int c = (n - 2720) & 127, g = c >> 6, d = c & 63;
        if (seg == 3 || seg == 5) {
          u16* dst = (u16*)(ws + (seg == 3 ? OFF_VST : OFF_VWT)) + ((size_t)((b * 2 + g) * 64 + d)) * S + permq(s);
          store_quad(dst, v0, v1, v2, v3);
        } else {
          const size_t off = seg == 0 ? OFF_KCMP : seg == 1 ? OFF_VCMP : seg == 2 ? OFF_KSLC : OFF_KWIN;
          store_rows((u16*)(ws + off) + (size_t)(b * 2 + g) * S * 64, 64, s, d, v0, v1, v2, v3);
        }
      } else if (n < N1) {
        float* gp = (float*)(ws + OFF_G) + (size_t)m * 24 + (n - 3488);
        gp[0] = v0; gp[24] = v1; gp[48] = v2; gp[72] = v3;
      }
    });
  }
}

struct TokRegs {
  u32x4 uc, ux, ub;
  unsigned cq[3];
  u32x2 ckv;
  int pos;
  u16 q1, q2, k1, k2, r1, r2;
};
DI void phaseB(const Params& p, int l) {
  const int lane = otid() & 63, gw = blockIdx.x * 8 + (otid() >> 6), nw = gridDim.x * 8;
  char* ws = wsp(p);
  const u16* P1A = (const u16*)(ws + OFF_P1A);
  u16* P1B = (u16*)(ws + OFF_P1B);
  const float* cw = (const float*)inp(p, 5) + (size_t)l * 3 * 512;
  const float* qn = (const float*)inp(p, 6) + (size_t)l * 384;
  const float* kvn = (const float*)inp(p, 8) + (size_t)l * 256;
  const int* posp = (const int*)inp(p, 1);
  const int c0 = lane * 8;
  float w[3][8];
#pragma unroll
  for (int k = 0; k < 3; ++k) {
    const f32x4 x0 = *(const f32x4*)(cw + k * 512 + c0), x1 = *(const f32x4*)(cw + k * 512 + c0 + 4);
    w[k][0] = x0.x; w[k][1] = x0.y; w[k][2] = x0.z; w[k][3] = x0.w; w[k][4] = x1.x; w[k][5] = x1.y; w[k][6] = x1.z; w[k][7] = x1.w;
  }
  float gq[6];
#pragma unroll
  for (int i = 0; i < 3; ++i) { gq[2 * i] = qn[lane * 2 + 128 * i]; gq[2 * i + 1] = qn[lane * 2 + 128 * i + 1]; }
  const f32x4 gkv = *(const f32x4*)(kvn + lane * 4);
  const int ri = lane & 7;
  const int ktn = lane >> 4, kg = (lane >> 3) & 1;
  const size_t koffb = ktn == 0 ? OFF_KCMP : ktn == 1 ? OFF_KSLC : OFF_KWIN;
  auto qptr = [&](int b, int s) { return (u16*)(ws + OFF_QN) + ((size_t)(b * 8 + (lane >> 3)) * S + s) * 64 + ri; };
  auto kptr = [&](int b, int s) { return (u16*)(ws + koffb) + ((size_t)(b * 2 + kg) * S + s) * 64 + ri; };
  auto loads = [&](int t, TokRegs& g) {
    const int b = t >> 13, s = t & (S - 1);
    const u16* row = P1A + (size_t)t * 1536;
    g.ub = __builtin_nontemporal_load((const u32x4*)(row + c0));
    g.uc = __builtin_nontemporal_load((const u32x4*)(row + 512 + c0));
    g.ux = __builtin_nontemporal_load((const u32x4*)(row + 1024 + c0));
    const u16* pb = P1B + (size_t)t * 672;
#pragma unroll
    for (int i = 0; i < 3; ++i) g.cq[i] = *(const unsigned*)(pb + lane * 2 + 128 * i);
    g.ckv = *(const u32x2*)(pb + 384 + lane * 4);
    g.pos = posp[t];
    const u16* q = qptr(b, s);
    g.q1 = q[0]; g.q2 = q[8];
    g.k1 = 0; g.k2 = 0; g.r1 = 0; g.r2 = 0;
    if (lane < 48) { const u16* k = kptr(b, s); g.k1 = k[0]; g.k2 = k[8]; }
    if (lane < 16) { g.r1 = pb[640 + lane]; g.r2 = pb[656 + lane]; }
  };
  constexpr int RUN = 16;
  for (int run = gw; run < T / RUN; run += nw) {
    const int t0 = run * RUN, s0 = t0 & (S - 1);
    float um2[8], um1[8];
#pragma unroll
    for (int j = 0; j < 8; ++j) { um2[j] = 0.f; um1[j] = 0.f; }
    if (s0 > 0) {
      const u16* r2 = P1A + (size_t)(t0 - 2) * 1536;
      const u16* r1 = P1A + (size_t)(t0 - 1) * 1536;
      const u32x4 c2 = *(const u32x4*)(r2 + 512 + c0), x2 = *(const u32x4*)(r2 + 1024 + c0);
      const u32x4 c1 = *(const u32x4*)(r1 + 512 + c0), x1 = *(const u32x4*)(r1 + 1024 + c0);
      um2[0] = bflo(c2.x) * bflo(x2.x); um2[1] = bfhi(c2.x) * bfhi(x2.x); um2[2] = bflo(c2.y) * bflo(x2.y); um2[3] = bfhi(c2.y) * bfhi(x2.y);
      um2[4] = bflo(c2.z) * bflo(x2.z); um2[5] = bfhi(c2.z) * bfhi(x2.z); um2[6] = bflo(c2.w) * bflo(x2.w); um2[7] = bfhi(c2.w) * bfhi(x2.w);
      um1[0] = bflo(c1.x) * bflo(x1.x); um1[1] = bfhi(c1.x) * bfhi(x1.x); um1[2] = bflo(c1.y) * bflo(x1.y); um1[3] = bfhi(c1.y) * bfhi(x1.y);
      um1[4] = bflo(c1.z) * bflo(x1.z); um1[5] = bfhi(c1.z) * bfhi(x1.z); um1[6] = bflo(c1.w) * bflo(x1.w); um1[7] = bfhi(c1.w) * bfhi(x1.w);
    }
    TokRegs cur, nxt;
    loads(t0, cur);
    for (int tt = 0; tt < RUN; ++tt) {
      const int t = t0 + tt, b = t >> 13, s = t & (S - 1);
      if (tt + 1 < RUN) loads(t + 1, nxt);
      {
        const float cc[8] = {bflo(cur.uc.x), bfhi(cur.uc.x), bflo(cur.uc.y), bfhi(cur.uc.y), bflo(cur.uc.z), bfhi(cur.uc.z), bflo(cur.uc.w), bfhi(cur.uc.w)};
        const float cx[8] = {bflo(cur.ux.x), bfhi(cur.ux.x), bflo(cur.ux.y), bfhi(cur.ux.y), bflo(cur.ux.z), bfhi(cur.ux.z), bflo(cur.ux.w), bfhi(cur.ux.w)};
        const float cb[8] = {bflo(cur.ub.x), bfhi(cur.ub.x), bflo(cur.ub.y), bfhi(cur.ub.y), bflo(cur.ub.z), bfhi(cur.ub.z), bflo(cur.ub.w), bfhi(cur.ub.w)};
        float y[8];
#pragma unroll
        for (int j = 0; j < 8; ++j) {
          const float u0 = cc[j] * cx[j];
          y[j] = cb[j] * (w[0][j] * um2[j] + w[1][j] * um1[j] + w[2][j] * u0);
          um2[j] = um1[j];
          um1[j] = u0;
        }
        *(u32x4*)((u16*)(ws + OFF_YCONV) + (size_t)t * 512 + c0) = mk_u4(pack2(y[0], y[1]), pack2(y[2], y[3]), pack2(y[4], y[5]), pack2(y[6], y[7]));
      }
      u16* pb = P1B + (size_t)t * 672;
      {
        float v[6];
#pragma unroll
        for (int i = 0; i < 3; ++i) { v[2 * i] = bflo(cur.cq[i]); v[2 * i + 1] = bfhi(cur.cq[i]); }
        const float k0 = bflo(cur.ckv.x), k1 = bfhi(cur.ckv.x), k2 = bflo(cur.ckv.y), k3 = bfhi(cur.ckv.y);
        float s1 = v[0] * v[0] + v[1] * v[1] + v[2] * v[2] + v[3] * v[3] + v[4] * v[4] + v[5] * v[5];
        float s2 = k0 * k0 + k1 * k1 + k2 * k2 + k3 * k3;
#pragma unroll
        for (int off = 32; off > 0; off >>= 1) { s1 += __shfl_xor(s1, off, 64); s2 += __shfl_xor(s2, off, 64); }
        const float rs1 = rsqrtf(s1 * (1.f / 384.f) + 1e-6f), rs2 = rsqrtf(s2 * (1.f / 256.f) + 1e-6f);
#pragma unroll
        for (int i = 0; i < 3; ++i) *(unsigned*)(pb + lane * 2 + 128 * i) = pack2(v[2 * i] * rs1 * gq[2 * i], v[2 * i + 1] * rs1 * gq[2 * i + 1]);
        u32x2 o;
        o.x = pack2(k0 * rs2 * gkv.x, k1 * rs2 * gkv.y);
        o.y = pack2(k2 * rs2 * gkv.z, k3 * rs2 * gkv.w);
        *(u32x2*)(pb + 384 + lane * 4) = o;
      }
      {
        float c, sn;
        sincos_pos(cur.pos, INVF[2 * ri], c, sn);
        {
          u16* q = qptr(b, s);
          const float x1 = bf2f(cur.q1), x2 = bf2f(cur.q2);
          q[0] = f2bf(x1 * c - x2 * sn);
          q[8] = f2bf(x2 * c + x1 * sn);
        }
        if (lane < 48) {
          u16* k = kptr(b, s);
          const float x1 = bf2f(cur.k1), x2 = bf2f(cur.k2);
          k[0] = f2bf(x1 * c - x2 * sn);
          k[8] = f2bf(x2 * c + x1 * sn);
        }
      }
      if (lane < 16) {
        float c, sn;
        sincos_pos(cur.pos, INVF[lane], c, sn);
        const float x1 = bf2f(cur.r1), x2 = bf2f(cur.r2);
        const u16 r1 = f2bf(x1 * c - x2 * sn), r2 = f2bf(x2 * c + x1 * sn);
#pragma unroll
        for (int hd = 0; hd < 8; ++hd) {
          u16* k = (u16*)(ws + OFF_KMLA) + ((size_t)(b * 8 + hd) * S + s) * 96;
          k[64 + lane] = r1;
          k[80 + lane] = r2;
        }
      }
      cur = nxt;
    }
  }
}

DI void phaseC(const Params& p, int l, char* lds) {
  char* ws = wsp(p);
  const u16* wl = (const u16*)wsp(p) + (size_t)l * W_LAYER;
  const u16* P1B = (const u16*)(wsp(p) + OFF_P1B);
  const float* bias = (const float*)(wsp(p) + OFF_BIAS) + l * 128;
  constexpr int NT_Q = 128 * 6, NT_KV = 128 * 4, NT_C = 32;
  for (int tile0 = blockIdx.x; tile0 < NT_KV + NT_Q + NT_C; tile0 += gridDim.x) {
    const int tile = tile0 < NT_C ? NT_KV + NT_Q + tile0 : tile0 - NT_C;
    if (tile < NT_KV) {
      const int mt = tile >> 2, nt = tile & 3;
      const int m0 = mt * 256, n0 = nt * 256;
      f32x16 acc[4][2];
      zero_acc<2>(acc);
      gemm_acc<2>(P1B + (size_t)m0 * 672 + 384, 672, wl + W_UKV + (size_t)n0 * 256, 256, 256, acc, lds);
      epi_apply<2>(acc, m0, n0, [&](int m, int n, float v0, float v1, float v2, float v3) {
        const int b = m >> 13, s = m & (S - 1), hd = n >> 7, c = n & 127;
        if (c < 64) {
          store_rows((u16*)(ws + OFF_KMLA) + (size_t)(b * 8 + hd) * S * 96, 96, s, c, v0, v1, v2, v3);
        } else {
          u16* dst = (u16*)(ws + OFF_VTMLA) + ((size_t)((b * 8 + hd) * 64 + (c - 64))) * S + permq(s);
          store_quad(dst, v0, v1, v2, v3);
        }
      });
    } else if (tile < NT_KV + NT_Q) {
      const int t2 = tile - NT_KV;
      const int mt = t2 / 6, nt = t2 % 6;
      const int m0 = mt * 256, n0 = nt * 128;
      f32x16 acc[4][1];
      zero_acc<1>(acc);
      gemm_acc<1>(P1B + (size_t)m0 * 672, 672, wl + W_UQ + (size_t)n0 * 384, 384, 384, acc, lds);
      epi_apply<1>(acc, m0, n0, [&](int m, int n, float v0, float v1, float v2, float v3) {
        const int b = m >> 13, s = m & (S - 1), hd = n / 96, c = n % 96;
        store_rows((u16*)(ws + OFF_QMLA) + (size_t)(b * 8 + hd) * S * 96, 96, s, c, v0, v1, v2, v3);
      });
    } else {
      const int t2 = tile - NT_KV - NT_Q;
      const int kv = t2 >> 4, slab = (t2 >> 1) & 7, mt = t2 & 1;
      const u16* Ab = (const u16*)(ws + (kv ? OFF_VCMP : OFF_KCMP)) + (size_t)slab * S * 64 + (size_t)(mt * 256) * 1024;
      f32x16 acc[4][1];
      zero_acc<1>(acc);
      gemm_acc<1>(Ab, 1024, wl + (kv ? W_CV : W_CK), 2048, 2048, acc, lds);
      const float* bs = bias + kv * 64;
      epi_apply<1>(acc, mt * 256, 0, [&](int m, int n, float v0, float v1, float v2, float v3) {
        if (n >= 64) return;
        const float bb = bs[n];
        v0 += bb; v1 += bb; v2 += bb; v3 += bb;
        if (m + 3 >= 511) v3 = 0.f;
        if (kv == 0) {
          store_rows((u16*)(ws + OFF_KC) + (size_t)slab * 512 * 64, 64, m, n, v0, v1, v2, v3);
        } else {
          u16* dst = (u16*)(ws + OFF_VCT) + ((size_t)(slab * 64 + n)) * 512 + permq(m);
          store_quad(dst, v0, v1, v2, v3);
        }
      });
    }
  }
}

constexpr float C_MLA = 0.14724444602590306f;
constexpr float C_NSA = 0.18033688011112042f;

DI bf16x8 pack8(const f32x16& x, int s2) {
  u32x4 u;
  u.x = pack2(x[8 * s2 + 0], x[8 * s2 + 1]);
  u.y = pack2(x[8 * s2 + 2], x[8 * s2 + 3]);
  u.z = pack2(x[8 * s2 + 4], x[8 * s2 + 5]);
  u.w = pack2(x[8 * s2 + 6], x[8 * s2 + 7]);
  return __builtin_bit_cast(bf16x8, u);
}
DI bf16x8 frag128(const char* base, int row, int chunk) { return *(const bf16x8*)(base + row * 128 + ((chunk ^ ((row >> 1) & 7)) << 4)); }
DI bf16x8 frag256(const char* base, int row, int chunk) { return *(const bf16x8*)(base + row * 256 + ((chunk ^ (row & 15)) << 4)); }

template <bool MASKED>
DI void softmax_step(f32x16 (&sc)[2], const float C, float& m, float& lsum, f32x16 (&o)[2], int kbase, int lo, int hi, bool lane_on, int hh,
                     const bf16x8 (&vf)[2][2][2]) {
  float mx;
  if (MASKED) {
    mx = -1e30f;
#pragma unroll
    for (int kb = 0; kb < 2; ++kb)
#pragma unroll
      for (int i = 0; i < 16; ++i) {
        const int key = kbase + 32 * kb + crow(i, hh);
        mx = fmaxf(mx, (key <= hi && key > lo) ? sc[kb][i] : -1e30f);
      }
  } else {
    float a0 = fmaxf(fmaxf(sc[0][0], sc[0][1]), sc[0][2]);
    float a1 = fmaxf(fmaxf(sc[1][0], sc[1][1]), sc[1][2]);
#pragma unroll
    for (int i = 3; i < 15; i += 2) {
      a0 = fmaxf(fmaxf(a0, sc[0][i]), sc[0][i + 1]);
      a1 = fmaxf(fmaxf(a1, sc[1][i]), sc[1][i + 1]);
    }
    mx = fmaxf(fmaxf(a0, a1), fmaxf(sc[0][15], sc[1][15]));
  }
  if (!lane_on) mx = -1e30f;
  mx = fmaxf(mx, __shfl_xor(mx, 32, 64));
  if (__any((mx - m) * C > 8.f)) {
    const float mn = fmaxf(m, mx);
    const float alpha = __builtin_amdgcn_exp2f((m - mn) * C);
    m = mn;
    lsum *= alpha;
    o[0] = o[0] * alpha;
    o[1] = o[1] * alpha;
  }
  const float mc = lane_on ? m * C : 3e38f;
  f32x16 t0 = sc[0] * C - mc;
#pragma unroll
  for (int i = 0; i < 16; ++i) t0[i] = __builtin_amdgcn_exp2f(t0[i]);
  if (MASKED) {
#pragma unroll
    for (int i = 0; i < 16; ++i) {
      const int key0 = kbase + crow(i, hh);
      t0[i] = (key0 <= hi && key0 > lo) ? t0[i] : 0.f;
    }
  }
#pragma unroll
  for (int s2 = 0; s2 < 2; ++s2) {
    const bf16x8 pb = pack8(t0, s2);
#pragma unroll
    for (int dvb = 0; dvb < 2; ++dvb) o[dvb] = MFMA(vf[0][s2][dvb], pb, o[dvb]);
  }
  f32x16 t1 = sc[1] * C - mc;
#pragma unroll
  for (int i = 0; i < 16; ++i) t1[i] = __builtin_amdgcn_exp2f(t1[i]);
  if (MASKED) {
#pragma unroll
    for (int i = 0; i < 16; ++i) {
      const int key1 = kbase + 32 + crow(i, hh);
      t1[i] = (key1 <= hi && key1 > lo) ? t1[i] : 0.f;
    }
  }
#pragma unroll
  for (int s2 = 0; s2 < 2; ++s2) {
    const bf16x8 pb = pack8(t1, s2);
#pragma unroll
    for (int dvb = 0; dvb < 2; ++dvb) o[dvb] = MFMA(vf[1][s2][dvb], pb, o[dvb]);
  }
  const f32x16 sv = t0 + t1;
  typedef float f32x8 __attribute__((ext_vector_type(8)));
  typedef float f32x4v __attribute__((ext_vector_type(4)));
  typedef float f32x2v __attribute__((ext_vector_type(2)));
  const f32x8 s8 = __builtin_shufflevector(sv, sv, 0, 1, 2, 3, 4, 5, 6, 7) + __builtin_shufflevector(sv, sv, 8, 9, 10, 11, 12, 13, 14, 15);
  const f32x4v s4 = __builtin_shufflevector(s8, s8, 0, 1, 2, 3) + __builtin_shufflevector(s8, s8, 4, 5, 6, 7);
  const f32x2v s2 = __builtin_shufflevector(s4, s4, 0, 1) + __builtin_shufflevector(s4, s4, 2, 3);
  lsum += s2[0] + s2[1];
}

DI void mla_tile(const Params& p, int tile, char* lds) {
  const int tid = otid(), lane = tid & 63, w = tid >> 6, r = lane & 31, hh = lane >> 5;
  const int qt = 31 - (tile >> 5), bh = tile & 31, b = bh >> 3, hd = bh & 7;
  const int q0 = qt * 256, qw0 = q0 + 32 * w, q = qw0 + r;
  bf16x8 qf[6];
  {
    const u16* Qp = (const u16*)(wsp(p) + OFF_QMLA) + ((size_t)bh * S + q) * 96 + 8 * hh;
#pragma unroll
    for (int s = 0; s < 6; ++s) qf[s] = *(const bf16x8*)(Qp + 16 * s);
    const int pos = ((const int*)inp(p, 1))[b * S + q];
#pragma unroll
    for (int j = 0; j < 8; ++j) {
      float c, sn;
      sincos_pos(pos, INVF[8 * hh + j], c, sn);
      const float x1 = bf2f((u16)qf[4][j]), x2 = bf2f((u16)qf[5][j]);
      qf[4][j] = (short)f2bf(x1 * c - x2 * sn);
      qf[5][j] = (short)f2bf(x2 * c + x1 * sn);
    }
  }
  const u16* Kg = (const u16*)(wsp(p) + OFF_KMLA) + (size_t)bh * S * 96;
  const u16* Vg = (const u16*)(wsp(p) + OFF_VTMLA) + (size_t)bh * 64 * S;
  int koff[2], voff;
#pragma unroll
  for (int i = 0; i < 2; ++i) {
    const int id = tid + 512 * i, row = id / 12, c = id % 12;
    koff[i] = row * 256 + ((c ^ (row & 15)) << 4);
  }
  {
    const int row = tid >> 3, c = tid & 7;
    voff = 16384 + row * 128 + ((c ^ ((row >> 1) & 7)) << 4);
  }
  u32x4 rk[2], rv;
  auto gload = [&](int kt) {
    rk[0] = *(const u32x4*)(Kg + (size_t)kt * 64 * 96 + (size_t)tid * 8);
    if (tid < 256) rk[1] = *(const u32x4*)(Kg + (size_t)kt * 64 * 96 + (size_t)(tid + 512) * 8);
    rv = *(const u32x4*)(Vg + (size_t)(tid >> 3) * S + kt * 64 + (tid & 7) * 8);
  };
  f32x16 o[2];
  o[0] = zero16(); o[1] = zero16();
  float m = -1e30f, lsum = 0.f;
  const int nkt = 4 * qt + 4;
  gload(0);
  for (int kt = 0; kt < nkt; ++kt) {
    char* st = lds + (kt & 1) * 24576;
    *(u32x4*)(st + koff[0]) = rk[0];
    if (tid < 256) *(u32x4*)(st + koff[1]) = rk[1];
    *(u32x4*)(st + voff) = rv;
    __syncthreads();
    if (kt + 1 < nkt) gload(kt + 1);
    const int k0 = kt * 64;
    if (k0 <= qw0 + 31) {
      f32x16 sc[2];
      {
        bf16x8 kf[2][6];
#pragma unroll
        for (int kb = 0; kb < 2; ++kb)
#pragma unroll
          for (int s = 0; s < 6; ++s) kf[kb][s] = frag256(st, 32 * kb + r, 2 * s + hh);
        asm volatile("" ::: "memory");
#pragma unroll
        for (int kb = 0; kb < 2; ++kb) {
          sc[kb] = zero16();
#pragma unroll
          for (int s = 0; s < 6; ++s) sc[kb] = MFMA(kf[kb][s], qf[s], sc[kb]);
        }
      }
      bf16x8 vf[2][2][2];
#pragma unroll
      for (int kb = 0; kb < 2; ++kb)
#pragma unroll
        for (int s2 = 0; s2 < 2; ++s2)
#pragma unroll
          for (int dvb = 0; dvb < 2; ++dvb) vf[kb][s2][dvb] = frag128(st + 16384, 32 * dvb + r, 4 * kb + 2 * s2 + hh);
      asm volatile("" ::: "memory");
      if (k0 + 63 > qw0) softmax_step<true>(sc, C_MLA, m, lsum, o, k0, -1, q, true, hh, vf);
      else softmax_step<false>(sc, C_MLA, m, lsum, o, k0, -1, q, true, hh, vf);
    }
  }
  __syncthreads();
  lsum += __shfl_xor(lsum, 32, 64);
  const float inv = 1.f / lsum;
  u16* yo = (u16*)(wsp(p) + OFF_YMLA) + (size_t)(b * S + q) * 512 + hd * 64;
#pragma unroll
  for (int dvb = 0; dvb < 2; ++dvb)
#pragma unroll
    for (int g4 = 0; g4 < 4; ++g4)
      store_quad(yo + 32 * dvb + 8 * g4 + 4 * hh, o[dvb][4 * g4] * inv, o[dvb][4 * g4 + 1] * inv, o[dvb][4 * g4 + 2] * inv, o[dvb][4 * g4 + 3] * inv);
}

struct KVRegs { u32x4 k, v; };
DI void kv_gload(KVRegs& rg, const u16* Kg, const u16* Vg, size_t vld, int kt, int tid, bool with_v) {
  rg.k = *(const u32x4*)(Kg + (size_t)kt * 4096 + (size_t)tid * 8);
  if (with_v) rg.v = *(const u32x4*)(Vg + (size_t)(tid >> 3) * vld + kt * 64 + (tid & 7) * 8);
}
DI void kv_store(const KVRegs& rg, char* st, int tid, bool with_v) {
  const int row = tid >> 3, c = tid & 7;
  const int off = row * 128 + ((c ^ ((row >> 1) & 7)) << 4);
  *(u32x4*)(st + off) = rg.k;
  if (with_v) *(u32x4*)(st + 8192 + off) = rg.v;
}

DI void cmp_tile(const Params& p, int tile, char* lds) {
  const int tid = otid(), lane = tid & 63, w = tid >> 6, r = lane & 31, hh = lane >> 5;
  const int slab = tile & 7, qt = 127 - (tile >> 3), b = slab >> 1, g = slab & 1;
  const int q0 = qt * 64, tl = 8 * w + (r >> 2), tok = q0 + tl, head = g * 4 + (r & 3);
  bf16x8 qf[4];
  {
    const u16* Qp = (const u16*)(wsp(p) + OFF_QN) + ((size_t)(b * 8 + head) * S + tok) * 64 + 8 * hh;
#pragma unroll
    for (int s = 0; s < 4; ++s) qf[s] = *(const bf16x8*)(Qp + 16 * s);
  }
  float* imp = (float*)(lds + 32768);
#pragma unroll
  for (int i = 0; i < 16; ++i) imp[tid + 512 * i] = 0.f;
  const u16* Kg = (const u16*)(wsp(p) + OFF_KC) + (size_t)slab * 512 * 64;
  const u16* Vg = (const u16*)(wsp(p) + OFF_VCT) + (size_t)slab * 64 * 512;
  const int nkt = ((q0 + 32) >> 10) + 1;
  const int lim = tok - 31;
  KVRegs rg;
  float m = -1e30f, lsum = 0.f;
  kv_gload(rg, Kg, Vg, 512, 0, tid, false);
  for (int kt = 0; kt < nkt; ++kt) {
    char* st = lds + (kt & 1) * 16384;
    kv_store(rg, st, tid, false);
    __syncthreads();
    if (kt + 1 < nkt) kv_gload(rg, Kg, Vg, 512, kt + 1, tid, false);
    f32x16 sc[2];
#pragma unroll
    for (int kb = 0; kb < 2; ++kb) {
      sc[kb] = zero16();
#pragma unroll
      for (int s = 0; s < 4; ++s) sc[kb] = MFMA(frag128(st, 32 * kb + r, 2 * s + hh), qf[s], sc[kb]);
    }
    float mx = -1e30f;
#pragma unroll
    for (int kb = 0; kb < 2; ++kb)
#pragma unroll
      for (int i = 0; i < 16; ++i) {
        const int n = kt * 64 + 32 * kb + crow(i, hh);
        mx = fmaxf(mx, (16 * n <= lim) ? sc[kb][i] : -1e30f);
      }
    mx = fmaxf(mx, __shfl_xor(mx, 32, 64));
    const float mn = fmaxf(m, mx);
    const float alpha = __builtin_amdgcn_exp2f((m - mn) * C_NSA);
    m = mn;
    const float mc = mn * C_NSA;
    float rs = 0.f;
#pragma unroll
    for (int kb = 0; kb < 2; ++kb)
#pragma unroll
      for (int i = 0; i < 16; ++i) {
        const int n = kt * 64 + 32 * kb + crow(i, hh);
        const float pv = __builtin_amdgcn_exp2f(sc[kb][i] * C_NSA - mc);
        rs += (16 * n <= lim) ? pv : 0.f;
      }
    lsum = lsum * alpha + rs;
  }
  __syncthreads();
  lsum += __shfl_xor(lsum, 32, 64);
  const float invl = lsum > 0.f ? 1.f / lsum : 0.f;
  const float mc = m * C_NSA;
  f32x16 o[2];
  o[0] = zero16(); o[1] = zero16();
  float carry = 0.f;
  kv_gload(rg, Kg, Vg, 512, 0, tid, true);
  for (int kt = 0; kt < nkt; ++kt) {
    char* st = lds + (kt & 1) * 16384;
    kv_store(rg, st, tid, true);
    __syncthreads();
    if (kt + 1 < nkt) kv_gload(rg, Kg, Vg, 512, kt + 1, tid, true);
    f32x16 sc[2];
#pragma unroll
    for (int kb = 0; kb < 2; ++kb) {
      sc[kb] = zero16();
#pragma unroll
      for (int s = 0; s < 4; ++s) sc[kb] = MFMA(frag128(st, 32 * kb + r, 2 * s + hh), qf[s], sc[kb]);
    }
#pragma unroll
    for (int kb = 0; kb < 2; ++kb) {
#pragma unroll
      for (int i = 0; i < 16; ++i) {
        const int n = kt * 64 + 32 * kb + crow(i, hh);
        const float pv = __builtin_amdgcn_exp2f(sc[kb][i] * C_NSA - mc) * invl;
        sc[kb][i] = (16 * n <= lim) ? pv : 0.f;
      }
      float qs[4], ls[4], rc[4];
#pragma unroll
      for (int g4 = 0; g4 < 4; ++g4) {
        qs[g4] = (sc[kb][4 * g4] + sc[kb][4 * g4 + 1]) + (sc[kb][4 * g4 + 2] + sc[kb][4 * g4 + 3]);
        ls[g4] = sc[kb][4 * g4 + 3];
        qs[g4] += __shfl_xor(qs[g4], 1, 64);
        qs[g4] += __shfl_xor(qs[g4], 2, 64);
        ls[g4] += __shfl_xor(ls[g4], 1, 64);
        ls[g4] += __shfl_xor(ls[g4], 2, 64);
      }
#pragma unroll
      for (int g4 = 0; g4 < 4; ++g4) rc[g4] = __shfl_xor(ls[g4], 32, 64);
#pragma unroll
      for (int g4 = 0; g4 < 4; ++g4) {
        const float prev = (g4 > 0) ? rc[g4 > 0 ? g4 - 1 : 0] : carry;
        const float val = qs[g4] + (hh ? rc[g4] : prev);
        const int Q = 16 * kt + 8 * kb + 2 * g4 + hh;
        if ((r & 3) == 0) imp[tl * 128 + Q] = val;
      }
      carry = rc[3];
    }
#pragma unroll
    for (int kb = 0; kb < 2; ++kb)
#pragma unroll
      for (int s2 = 0; s2 < 2; ++s2) {
        const bf16x8 pb = pack8(sc[kb], s2);
#pragma unroll
        for (int dvb = 0; dvb < 2; ++dvb) o[dvb] = MFMA(frag128(st + 8192, 32 * dvb + r, 4 * kb + 2 * s2 + hh), pb, o[dvb]);
      }
  }
  __syncthreads();
  {
    const float g0 = sigmoidf_(((const float*)(wsp(p) + OFF_G))[(size_t)(b * S + tok) * 24 + head * 3]);
    u16* yo = (u16*)(wsp(p) + OFF_YNSA) + (size_t)(b * S + tok) * 512 + head * 64;
#pragma unroll
    for (int dvb = 0; dvb < 2; ++dvb)
#pragma unroll
      for (int g4 = 0; g4 < 4; ++g4)
        store_quad(yo + 32 * dvb + 8 * g4 + 4 * hh, o[dvb][4 * g4] * g0, o[dvb][4 * g4 + 1] * g0, o[dvb][4 * g4 + 2] * g0, o[dvb][4 * g4 + 3] * g0);
  }
  float* vals = (float*)(lds + 65536) + w * 128;
  for (int tt = 0; tt < 8; ++tt) {
    const int tl2 = 8 * w + tt, tok2 = q0 + tl2, cur = tok2 >> 6;
    const int m1 = lane, m2 = lane + 64;
    const float v1 = (m1 == 0 || m1 == cur || m1 == cur - 1) ? 1e6f : (m1 <= cur ? imp[tl2 * 128 + m1] : -1.f);
    const float v2 = (m2 == cur || m2 == cur - 1) ? 1e6f : (m2 <= cur ? imp[tl2 * 128 + m2] : -1.f);
    vals[m1] = v1;
    vals[m2] = v2;
    asm volatile("s_waitcnt lgkmcnt(0)" ::: "memory");
    int c1 = 0, c2 = 128;
    if (cur >= 64) {
      c2 = 0;
      for (int j = 0; j <= cur; j += 4) {
        const f32x4 vj = *(const f32x4*)(vals + j);
        c1 += (vj.x > v1 || (vj.x == v1 && j < m1)) ? 1 : 0;
        c1 += (vj.y > v1 || (vj.y == v1 && j + 1 < m1)) ? 1 : 0;
        c1 += (vj.z > v1 || (vj.z == v1 && j + 2 < m1)) ? 1 : 0;
        c1 += (vj.w > v1 || (vj.w == v1 && j + 3 < m1)) ? 1 : 0;
        c2 += (vj.x > v2 || (vj.x == v2 && j < m2)) ? 1 : 0;
        c2 += (vj.y > v2 || (vj.y == v2 && j + 1 < m2)) ? 1 : 0;
        c2 += (vj.z > v2 || (vj.z == v2 && j + 2 < m2)) ? 1 : 0;
        c2 += (vj.w > v2 || (vj.w == v2 && j + 3 < m2)) ? 1 : 0;
      }
    } else {
      for (int j = 0; j <= cur; j += 4) {
        const f32x4 vj = *(const f32x4*)(vals + j);
        c1 += (vj.x > v1 || (vj.x == v1 && j < m1)) ? 1 : 0;
        c1 += (vj.y > v1 || (vj.y == v1 && j + 1 < m1)) ? 1 : 0;
        c1 += (vj.z > v1 || (vj.z == v1 && j + 2 < m1)) ? 1 : 0;
        c1 += (vj.w > v1 || (vj.w == v1 && j + 3 < m1)) ? 1 : 0;
      }
    }
    const unsigned long long b1 = __ballot(c1 < 16 && v1 >= 0.f);
    const unsigned long long b2 = __ballot(c2 < 16 && v2 >= 0.f);
    if (lane == 0)
      *(u32x4*)(wsp(p) + OFF_SEL + ((size_t)slab * S + tok2) * 16) = mk_u4((unsigned)b1, (unsigned)(b1 >> 32), (unsigned)b2, (unsigned)(b2 >> 32));
    asm volatile("s_waitcnt lgkmcnt(0)" ::: "memory");
  }
  __syncthreads();
}

DI void nsa_tile(const Params& p, int tile, char* lds) {
  const int tid = otid(), lane = tid & 63, w = tid >> 6, r = lane & 31, hh = lane >> 5;
  const int slab = tile & 7, qt = 127 - (tile >> 3), b = slab >> 1, g = slab & 1;
  const int q0 = qt * 64, tl = 8 * w + (r >> 2), tok = q0 + tl, head = g * 4 + (r & 3);
  bf16x8 qf[4];
  {
    const u16* Qp = (const u16*)(wsp(p) + OFF_QN) + ((size_t)(b * 8 + head) * S + tok) * 64 + 8 * hh;
#pragma unroll
    for (int s = 0; s < 4; ++s) qf[s] = *(const bf16x8*)(Qp + 16 * s);
  }
  const u32x4 sm = *(const u32x4*)(wsp(p) + OFF_SEL + ((size_t)slab * S + tok) * 16);
  const float* gp = (const float*)(wsp(p) + OFF_G) + (size_t)(b * S + tok) * 24 + head * 3;
  f32x16 outa[2];
  outa[0] = zero16(); outa[1] = zero16();
  KVRegs rg;
  for (int mode = 0; mode < 2; ++mode) {
    const u16* Kg = (const u16*)(wsp(p) + (mode ? OFF_KWIN : OFF_KSLC)) + (size_t)slab * S * 64;
    const u16* Vg = (const u16*)(wsp(p) + (mode ? OFF_VWT : OFF_VST)) + (size_t)slab * 64 * S;
    const int kt_lo = mode ? ((q0 > 511 ? q0 - 511 : 0) >> 6) : 0;
    const int kt_hi = q0 >> 6;
    const int lo = mode ? tok - 512 : -1;
    f32x16 o[2];
    o[0] = zero16(); o[1] = zero16();
    float m = -1e30f, lsum = 0.f;
    kv_gload(rg, Kg, Vg, S, kt_lo, tid, true);
    for (int kt = kt_lo; kt <= kt_hi; ++kt) {
      char* st = lds + ((kt - kt_lo) & 1) * 16384;
      kv_store(rg, st, tid, true);
      __syncthreads();
      if (kt < kt_hi) kv_gload(rg, Kg, Vg, S, kt + 1, tid, true);
      const unsigned word = kt < 32 ? sm.x : kt < 64 ? sm.y : kt < 96 ? sm.z : sm.w;
      const bool bit = mode ? true : (((word >> (kt & 31)) & 1u) != 0);
      if (__ballot(bit) != 0ull) {
        const int k0 = kt * 64;
        f32x16 sc[2];
        {
          bf16x8 kf[2][4];
#pragma unroll
          for (int kb = 0; kb < 2; ++kb)
#pragma unroll
            for (int s = 0; s < 4; ++s) kf[kb][s] = frag128(st, 32 * kb + r, 2 * s + hh);
          asm volatile("" ::: "memory");
#pragma unroll
          for (int kb = 0; kb < 2; ++kb) {
            sc[kb] = zero16();
#pragma unroll
            for (int s = 0; s < 4; ++s) sc[kb] = MFMA(kf[kb][s], qf[s], sc[kb]);
          }
        }
        bf16x8 vf[2][2][2];
#pragma unroll
        for (int kb = 0; kb < 2; ++kb)
#pragma unroll
          for (int s2 = 0; s2 < 2; ++s2)
#pragma unroll
            for (int dvb = 0; dvb < 2; ++dvb) vf[kb][s2][dvb] = frag128(st + 8192, 32 * dvb + r, 4 * kb + 2 * s2 + hh);
        asm volatile("" ::: "memory");
        const bool need_mask = (k0 + 63 > q0 + 8 * w) || (mode && k0 <= q0 + 8 * w + 7 - 512);
        if (need_mask) softmax_step<true>(sc, C_NSA, m, lsum, o, k0, lo, tok, bit, hh, vf);
        else softmax_step<false>(sc, C_NSA, m, lsum, o, k0, lo, tok, bit, hh, vf);
      }
    }
    __syncthreads();
    lsum += __shfl_xor(lsum, 32, 64);
    const float gate = sigmoidf_(gp[1 + mode]);
    const float sc_ = lsum > 0.f ? gate / lsum : 0.f;
#pragma unroll
    for (int i = 0; i < 16; ++i) { outa[0][i] += o[0][i] * sc_; outa[1][i] += o[1][i] * sc_; }
  }
  u16* yo = (u16*)(wsp(p) + OFF_YNSA) + (size_t)(b * S + tok) * 512 + head * 64;
#pragma unroll
  for (int dvb = 0; dvb < 2; ++dvb)
#pragma unroll
    for (int g4 = 0; g4 < 4; ++g4) {
      u16* d = yo + 32 * dvb + 8 * g4 + 4 * hh;
      const u32x2 pc = *(const u32x2*)d;
      store_quad(d, outa[dvb][4 * g4] + bflo(pc.x), outa[dvb][4 * g4 + 1] + bfhi(pc.x), outa[dvb][4 * g4 + 2] + bflo(pc.y), outa[dvb][4 * g4 + 3] + bfhi(pc.y));
    }
}

DI void phaseF(const Params& p, int l, char* lds) {
  const u16* wl = (const u16*)wsp(p) + (size_t)l * W_LAYER;
  const u16* h = (const u16*)(wsp(p) + OFF_H);
  u16* merged = (u16*)(wsp(p) + OFF_MERGED);
  int pre = -1;
  for (int j = 0; j * (int)gridDim.x < 128 * 8; ++j) {
    int mt, nt;
    if (!tile_mn(j, 8, 128 * 8, mt, nt)) continue;
    int mt2 = 0, nt2 = 0;
    const bool has_next = ((j + 1) * (int)gridDim.x < 128 * 8) && tile_mn(j + 1, 8, 128 * 8, mt2, nt2);
    const int m0 = mt * 256, n0 = nt * 128;
    unsigned fpk[4][8];
#pragma unroll
    for (int mi = 0; mi < 4; ++mi)
#pragma unroll
      for (int e = 0; e < 8; ++e) fpk[mi][e] = 0u;
#pragma unroll 1
    for (int i = 0; i < 3; ++i) {
      unsigned gpk[4][8];
      {
        f32x16 ga[4][1];
        zero_acc<1>(ga);
        const u16* yb = (const u16*)(wsp(p) + (i == 0 ? OFF_YCONV : i == 1 ? OFF_YMLA : OFF_YNSA));
        const u16* wbb = wl + (i == 0 ? W_BC : i == 1 ? W_BM : W_BN);
        pre = gemm_acc_chain<1>(h + (size_t)m0 * 1024, 1024, wl + W_IN + (size_t)(i * 1024 + n0) * 1024, 1024, 1024, ga, lds, pre,
                                yb + (size_t)m0 * 512, 512, wbb + (size_t)n0 * 512, 512);
#pragma unroll
        for (int mi = 0; mi < 4; ++mi)
#pragma unroll
          for (int e = 0; e < 8; ++e) gpk[mi][e] = pack2(sigmoidf_(ga[mi][0][2 * e]), sigmoidf_(ga[mi][0][2 * e + 1]));
      }
      f32x16 ba[4][1];
      zero_acc<1>(ba);
      const u16* y = (const u16*)(wsp(p) + (i == 0 ? OFF_YCONV : i == 1 ? OFF_YMLA : OFF_YNSA));
      const u16* wb = wl + (i == 0 ? W_BC : i == 1 ? W_BM : W_BN);
      {
        const bool last = (i == 2);
        const u16* nA = last ? (has_next ? h + (size_t)(mt2 * 256) * 1024 : nullptr) : h + (size_t)m0 * 1024;
        const u16* nB = last ? wl + W_IN + (size_t)(nt2 * 128) * 1024 : wl + W_IN + (size_t)((i + 1) * 1024 + n0) * 1024;
        const int nb = gemm_acc_chain<1>(y + (size_t)m0 * 512, 512, wb + (size_t)n0 * 512, 512, 512, ba, lds, pre, nA, 1024, nB, 1024);
        pre = nA ? nb : -1;
      }
#pragma unroll
      for (int mi = 0; mi < 4; ++mi)
#pragma unroll
        for (int e = 0; e < 8; ++e)
          fpk[mi][e] = pack2(bflo(fpk[mi][e]) + bflo(gpk[mi][e]) * ba[mi][0][2 * e], bfhi(fpk[mi][e]) + bfhi(gpk[mi][e]) * ba[mi][0][2 * e + 1]);
    }
    {
      const int tid = otid(), lane = tid & 63, w = tid >> 6, r = lane & 31, hh = lane >> 5, wm = w >> 2, wn = w & 3;
#pragma unroll
      for (int mi = 0; mi < 4; ++mi)
#pragma unroll
        for (int g4 = 0; g4 < 4; ++g4) {
          const int m = m0 + 128 * wm + 32 * mi + 8 * g4 + 4 * hh;
          const int n = n0 + 32 * wn + r;
          u16* q = merged + (size_t)m * 1024 + n;
          q[0] = (u16)(fpk[mi][2 * g4] & 0xffffu);
          q[1024] = (u16)(fpk[mi][2 * g4] >> 16);
          q[2048] = (u16)(fpk[mi][2 * g4 + 1] & 0xffffu);
          q[3072] = (u16)(fpk[mi][2 * g4 + 1] >> 16);
        }
    }
  }
}

DI void gemm_phase(const u16* A, int lda, const u16* Bt, int K, int Ntiles, u16* C, int ldc, char* lds) {
  const int ntot = 128 * Ntiles;
  bool pre = false;
  for (int j = 0; j * (int)gridDim.x < ntot; ++j) {
    int mt, nt;
    if (!tile_mn(j, Ntiles, ntot, mt, nt)) continue;
    const int m0 = mt * 256, n0 = nt * 256;
    int mt2 = 0, nt2 = 0;
    const bool has_next = ((j + 1) * (int)gridDim.x < ntot) && tile_mn(j + 1, Ntiles, ntot, mt2, nt2);
    f32x4m acc[2][2][4][2];
    zero_acc8(acc);
    gemm8_acc(A + (size_t)m0 * lda, lda, Bt + (size_t)n0 * K, K, K, acc, lds, pre);
    if (has_next) gemm8_prologue(A + (size_t)(mt2 * 256) * lda, lda, Bt + (size_t)(nt2 * 256) * K, K, lds);
    pre = has_next;
    epi8_apply(acc, m0, n0, [&](int m, int n, float v0, float v1, float v2, float v3) { store_rows(C, ldc, m, n, v0, v1, v2, v3); });
  }
}

DI void phaseJ(const Params& p, int l) {
  u16* U = (u16*)(wsp(p) + OFF_U);
  const float* cw = (const float*)inp(p, 21) + (size_t)l * 3 * DFF;
  const float* cb = (const float*)inp(p, 22) + (size_t)l * DFF;
  const int nthr = gridDim.x * 512;
  constexpr int RUN = 16;
  for (int idx = blockIdx.x * 512 + otid(); idx < (T / RUN) * 352; idx += nthr) {
    const int run = idx / 352, c0 = (idx % 352) * 8;
    const int t0 = run * RUN, s0 = t0 & (S - 1);
    float w[3][8], bias[8], a0[8], a1[8];
#pragma unroll
    for (int k = 0; k < 3; ++k) {
      const f32x4 x0 = *(const f32x4*)(cw + k * DFF + c0), x1 = *(const f32x4*)(cw + k * DFF + c0 + 4);
      w[k][0] = x0.x; w[k][1] = x0.y; w[k][2] = x0.z; w[k][3] = x0.w; w[k][4] = x1.x; w[k][5] = x1.y; w[k][6] = x1.z; w[k][7] = x1.w;
    }
    {
      const f32x4 x0 = *(const f32x4*)(cb + c0), x1 = *(const f32x4*)(cb + c0 + 4);
      bias[0] = x0.x; bias[1] = x0.y; bias[2] = x0.z; bias[3] = x0.w; bias[4] = x1.x; bias[5] = x1.y; bias[6] = x1.z; bias[7] = x1.w;
    }
    {
      u32x4 u0 = mk_u4(0u, 0u, 0u, 0u), u1 = mk_u4(0u, 0u, 0u, 0u);
      if (s0 > 0) {
        u0 = *(const u32x4*)(U + (size_t)(t0 - 2) * 5632 + c0);
        u1 = *(const u32x4*)(U + (size_t)(t0 - 1) * 5632 + c0);
      }
      a0[0] = bflo(u0.x); a0[1] = bfhi(u0.x); a0[2] = bflo(u0.y); a0[3] = bfhi(u0.y); a0[4] = bflo(u0.z); a0[5] = bfhi(u0.z); a0[6] = bflo(u0.w); a0[7] = bfhi(u0.w);
      a1[0] = bflo(u1.x); a1[1] = bfhi(u1.x); a1[2] = bflo(u1.y); a1[3] = bfhi(u1.y); a1[4] = bflo(u1.z); a1[5] = bfhi(u1.z); a1[6] = bflo(u1.w); a1[7] = bfhi(u1.w);
    }
    for (int tb = 0; tb < RUN; tb += 8) {
      u32x4 uas[8], ubs[8];
#pragma unroll
      for (int q = 0; q < 8; ++q) {
        const u16* rowp = U + (size_t)(t0 + tb + q) * 5632 + c0;
        uas[q] = __builtin_nontemporal_load((const u32x4*)rowp);
        ubs[q] = __builtin_nontemporal_load((const u32x4*)(rowp + DFF));
      }
#pragma unroll
      for (int q = 0; q < 8; ++q) {
        const u32x4 ua = uas[q], ub = ubs[q];
        const float a2[8] = {bflo(ua.x), bfhi(ua.x), bflo(ua.y), bfhi(ua.y), bflo(ua.z), bfhi(ua.z), bflo(ua.w), bfhi(ua.w)};
        const float bv[8] = {bflo(ub.x), bfhi(ub.x), bflo(ub.y), bfhi(ub.y), bflo(ub.z), bfhi(ub.z), bflo(ub.w), bfhi(ub.w)};
        float z[8];
#pragma unroll
        for (int j = 0; j < 8; ++j) {
          const float x = bias[j] + w[0][j] * a0[j] + w[1][j] * a1[j] + w[2][j] * a2[j];
          const float u = 0.7978845608028654f * (x + 0.044715f * x * x * x);
          const float th = 1.f - 2.f / (__expf(2.f * u) + 1.f);
          z[j] = 0.5f * x * (1.f + th) * bv[j];
          a0[j] = a1[j];
          a1[j] = a2[j];
        }
        *(u32x4*)(U + (size_t)(t0 + tb + q) * 5632 + c0 + DFF) = mk_u4(pack2(z[0], z[1]), pack2(z[2], z[3]), pack2(z[4], z[5]), pack2(z[6], z[7]));
      }
    }
  }
}

#define XB_TMO      128
#define XB_XCNT(j)  (256  + 64 * (j))
#define XB_XSUB(j)  (1280 + 64 * (j))
#define XB_XGEN(j)  (2304 + 64 * (j))
#define XB_TOP      3328
#define XB_TOPGEN   3392
#define XCD_BAR_WORDS 3456
#define XB_SPIN_CAP (1u << 20)
#define LAS __attribute__((address_space(3)))
DI unsigned xb_ld(unsigned* p) { return __hip_atomic_load(p, __ATOMIC_RELAXED, __HIP_MEMORY_SCOPE_AGENT); }
DI unsigned xb_add(unsigned* p, unsigned v) { return __hip_atomic_fetch_add(p, v, __ATOMIC_RELAXED, __HIP_MEMORY_SCOPE_AGENT); }
DI unsigned xb_xcc_id() { return (unsigned)__builtin_amdgcn_s_getreg((3 << 11) | 20) & 0xFu; }
#define XB_SPIN(cond, bar) do { unsigned _sp = 0; while (cond) { __builtin_amdgcn_s_sleep(1); \
    if ((++_sp & 255u) == 0u) { if (xb_ld(&(bar)[XB_TMO])) break; if (_sp > XB_SPIN_CAP) { atomicAdd(&(bar)[XB_TMO], 1u); break; } } } } while (0)
struct XcdBarrier { unsigned* bar; unsigned x; volatile LAS unsigned* st; };
DI XcdBarrier xcd_barrier_post(unsigned* bar, volatile LAS unsigned* st) {
  XcdBarrier b; b.bar = bar; b.x = xb_xcc_id(); b.st = st;
  if (threadIdx.x == 0) (void)xb_add(&bar[XB_XCNT(b.x)], 1u);
  return b;
}
DI void xcd_barrier_complete(unsigned* bar, unsigned x, unsigned& nloc, unsigned& nx) {
  const unsigned G = gridDim.x * gridDim.y * gridDim.z;
  unsigned sum, cnt, mine, sp = 0u;
  for (;;) {
    sum = 0u; cnt = 0u; mine = 0u;
#pragma unroll
    for (unsigned j = 0; j < 16; ++j) { const unsigned c = xb_ld(&bar[XB_XCNT(j)]); sum += c; cnt += (c > 0u) ? 1u : 0u; mine = (j == x) ? c : mine; }
    if (sum == G) break;
    __builtin_amdgcn_s_sleep(1);
    if ((++sp & 255u) == 0u) { if (xb_ld(&bar[XB_TMO])) break; if (sp > XB_SPIN_CAP) { atomicAdd(&bar[XB_TMO], 1u); break; } }
  }
  nloc = mine > 0u ? mine : 1u; nx = cnt > 0u ? cnt : 1u;
}
DI void xcd_barrier(const XcdBarrier& b) {
  asm volatile("s_waitcnt vmcnt(0)" ::: "memory");
  __syncthreads();
  if (threadIdx.x == 0) {
    unsigned* bar = b.bar;
    __builtin_amdgcn_s_waitcnt(0);
    unsigned nloc = b.st[0], nx = b.st[1];
    if (nloc == 0u) { xcd_barrier_complete(bar, b.x, nloc, nx); b.st[0] = nloc; b.st[1] = nx; }
    const unsigned old = xb_add(&bar[XB_XSUB(b.x)], 1u);
    const unsigned gen = old / nloc;
    if (old + 1u == (gen + 1u) * nloc) {
      __builtin_amdgcn_fence(__ATOMIC_RELEASE, "agent");
      asm volatile("s_waitcnt vmcnt(0)" ::: "memory");
      const unsigned og = xb_add(&bar[XB_TOP], 1u);
      const unsigned tg = og / nx;
      if (og + 1u == (tg + 1u) * nx) xb_add(&bar[XB_TOPGEN], 1u);
      else XB_SPIN(xb_ld(&bar[XB_TOPGEN]) == tg, bar);
      __builtin_amdgcn_fence(__ATOMIC_ACQUIRE, "agent");
      xb_add(&bar[XB_XGEN(b.x)], 1u);
      asm volatile("s_waitcnt vmcnt(0)" ::: "memory");
    } else {
      XB_SPIN(xb_ld(&bar[XB_XGEN(b.x)]) == gen, bar);
      __builtin_amdgcn_fence(__ATOMIC_ACQUIRE, "agent");
      asm volatile("s_waitcnt vmcnt(0)" ::: "memory");
    }
  }
  __syncthreads();
}

__global__ void __launch_bounds__(512, 2) fwd_megakernel(Params p) {
  __shared__ __attribute__((aligned(1024))) char lds[131072 + 1024];
  cg::grid_group grid = cg::this_grid();
  if (threadIdx.x < 4) ((unsigned*)(lds + 131072))[threadIdx.x] = 0u;
  __syncthreads();
  XcdBarrier xb = xcd_barrier_post((unsigned*)(p.ws + OFF_BAR), (volatile LAS unsigned*)(lds + 131072));
  const int lane = otid() & 63, gw = blockIdx.x * 8 + (otid() >> 6), nw = gridDim.x * 8;
  phase0(p, lds);
  grid.sync();
  for (int l = 0; l < 2; ++l) {
    const u16* wl = (const u16*)wsp(p) + (size_t)l * W_LAYER;
    phaseA(p, l, lds);
    xcd_barrier(xb);
    phaseB(p, l);
    xcd_barrier(xb);
    phaseC(p, l, lds);
    xcd_barrier(xb);
    for (int j = 0;; ++j) {
      int t2 = j * gridDim.x + blockIdx.x;
      if (j >= 7) {
        if (threadIdx.x == 0) ((volatile unsigned*)(lds + 131072))[6] = atomicAdd((unsigned*)(p.ws + OFF_BAR) + XCD_BAR_WORDS + 64 * l, 1u);
        __syncthreads();
        t2 = 7 * (int)gridDim.x + (int)((volatile unsigned*)(lds + 131072))[6];
        __syncthreads();
      }
      if (t2 >= 2048) break;
      if (j < 7 ? (((blockIdx.x + j) & 1) != 0) : ((t2 & 1) != 0)) {
        cmp_tile(p, t2 >> 1, lds);
        __threadfence_block();
        __syncthreads();
        nsa_tile(p, t2 >> 1, lds);
      } else {
        mla_tile(p, t2 >> 1, lds);
      }
    }
    xcd_barrier(xb);
    phaseF(p, l, lds);
    xcd_barrier(xb);
    gemm_phase((const u16*)(wsp(p) + OFF_MERGED), 1024, wl + W_OUT, 1024, 4, (u16*)(wsp(p) + OFF_O), 1024, lds);
    xcd_barrier(xb);
    {
      const float* xs = l == 0 ? (const float*)inp(p, 0) : p.out;
      rowpass_all(xs, p.out, (const u16*)(wsp(p) + OFF_O), (const float*)inp(p, 3) + l * 1024, (const float*)inp(p, 18) + l * 1024, (u16*)(wsp(p) + OFF_H));
    }
    xcd_barrier(xb);
    gemm_phase((const u16*)(wsp(p) + OFF_H), 1024, wl + W_UP, 1024, 22, (u16*)(wsp(p) + OFF_U), 5632, lds);
    xcd_barrier(xb);
    phaseJ(p, l);
    xcd_barrier(xb);
    gemm_phase((const u16*)(wsp(p) + OFF_U) + DFF, 5632, wl + W_DOWN, DFF, 4, (u16*)(wsp(p) + OFF_H), 1024, lds);
    xcd_barrier(xb);
    {
      const float* gnext = l == 0 ? (const float*)inp(p, 2) + 1024 : nullptr;
      rowpass_all(p.out, p.out, (const u16*)(wsp(p) + OFF_H), (const float*)inp(p, 19) + l * 1024, gnext, (u16*)(wsp(p) + OFF_H));
    }
    if (l == 0) xcd_barrier(xb);
  }
}

extern "C" void kernel_launch(void* const* d_in, const int* in_sizes, int n_in, void* d_out, int out_size, void* d_ws, size_t ws_size,
                              hipStream_t stream) {
  static int grid_blocks = 0;
  if (!grid_blocks) {
    int dev = 0, cus = 0, per_cu = 0;
    hipGetDevice(&dev);
    hipDeviceGetAttribute(&cus, hipDeviceAttributeMultiprocessorCount, dev);
    hipOccupancyMaxActiveBlocksPerMultiprocessor(&per_cu, fwd_megakernel, 512, 0);
    if (per_cu > 1) per_cu = 1;
    grid_blocks = cus * per_cu;
  }
  Params p{};
  for (int i = 0; i < 24; ++i) p.in[i] = d_in[i];
  p.out = (float*)d_out;
  p.ws = (char*)d_ws;
  hipMemsetAsync((char*)d_ws + OFF_BAR, 0, (XCD_BAR_WORDS + 256) * sizeof(unsigned), stream);
  void* args[] = {&p};
  hipError_t e = hipLaunchCooperativeKernel((void*)fwd_megakernel, dim3(grid_blocks), dim3(512), args, 0, stream);
  if (e != hipSuccess) fprintf(stderr, "cooperative launch failed: %s (grid %d)\n", hipGetErrorString(e), grid_blocks);
}
```

```cpp
#include <hip/hip_runtime.h>
#include <hip/hip_cooperative_groups.h>
#include <cstdio>
namespace cg = cooperative_groups;

#define DI __device__ __forceinline__
typedef unsigned short u16;
typedef short bf16x8 __attribute__((ext_vector_type(8)));
typedef float f32x16 __attribute__((ext_vector_type(16)));
typedef __bf16 bf2_t __attribute__((ext_vector_type(2)));
typedef float f2_t __attribute__((ext_vector_type(2)));
typedef unsigned u32x4 __attribute__((ext_vector_type(4)));
typedef unsigned u32x2 __attribute__((ext_vector_type(2)));
typedef float f32x4 __attribute__((ext_vector_type(4)));

constexpr int NB = 4, S = 8192, T = NB * S;
constexpr int N1 = 3512;
constexpr int DFF = 2816;
constexpr size_t MiB = 1ull << 20;

constexpr size_t W_IN = 0;
constexpr size_t W_UQ = W_IN + 6656ull * 1024;
constexpr size_t W_UKV = W_UQ + 768ull * 384;
constexpr size_t W_CK = W_UKV + 1024ull * 256;
constexpr size_t W_CV = W_CK + 64ull * 2048;
constexpr size_t W_BC = W_CV + 64ull * 2048;
constexpr size_t W_BM = W_BC + 1024ull * 512;
constexpr size_t W_BN = W_BM + 1024ull * 512;
constexpr size_t W_OUT = W_BN + 1024ull * 512;
constexpr size_t W_UP = W_OUT + 1024ull * 1024;
constexpr size_t W_DOWN = W_UP + 5632ull * 1024;
constexpr size_t W_LAYER = W_DOWN + 1024ull * 2816;

constexpr size_t OFF_BIAS = 73 * MiB;
constexpr size_t OFF_BAR = 73 * MiB + 65536;
constexpr size_t OFF_H = 74 * MiB;
constexpr size_t OFF_P1A = 138 * MiB;
constexpr size_t OFF_P1B = 234 * MiB;
constexpr size_t OFF_YCONV = 276 * MiB;
constexpr size_t OFF_QN = 308 * MiB;
constexpr size_t OFF_KCMP = 340 * MiB;
constexpr size_t OFF_VCMP = 348 * MiB;
constexpr size_t OFF_KSLC = 356 * MiB;
constexpr size_t OFF_KWIN = 364 * MiB;
constexpr size_t OFF_VST = 372 * MiB;
constexpr size_t OFF_VWT = 380 * MiB;
constexpr size_t OFF_G = 388 * MiB;
constexpr size_t OFF_KC = 391 * MiB;
constexpr size_t OFF_VCT = 391 * MiB + 512 * 1024;
constexpr size_t OFF_SEL = 392 * MiB;
constexpr size_t OFF_KMLA = 394 * MiB;
constexpr size_t OFF_YMLA = 442 * MiB;
constexpr size_t OFF_YNSA = 474 * MiB;
constexpr size_t OFF_QMLA = 138 * MiB;
constexpr size_t OFF_VTMLA = 186 * MiB;
constexpr size_t OFF_MERGED = 138 * MiB;
constexpr size_t OFF_O = 202 * MiB;
constexpr size_t OFF_U = 138 * MiB;

struct Params {
  const void* in[24];
  float* out;
  char* ws;
};

__device__ const double INVF[16] = {
    1.0, 0.44036660267178046, 0.19392274474868576, 0.08539710028576561, 0.03760603093086393, 0.016560440080994446,
    0.007292664737217109, 0.003211445994752591, 0.001414213562373095, 0.000622772421914596, 0.0002742481756762073,
    0.00012076973741146504, 5.318295896944988e-05, 2.341999896140934e-05, 1.031338537721246e-05, 4.5416704806078695e-06};

DI u32x4 mk_u4(unsigned a, unsigned b, unsigned c, unsigned d) { u32x4 v = {a, b, c, d}; return v; }
DI f32x4 mk_f4(float a, float b, float c, float d) { f32x4 v = {a, b, c, d}; return v; }
DI char* wsp(const Params& p) { size_t z = 0; asm volatile("" : "+s"(z)); return p.ws + z; }
DI const void* inp(const Params& p, int i) { size_t z = 0; asm volatile("" : "+s"(z)); return (const char*)p.in[i] + z; }
DI int otid() { int t = __builtin_amdgcn_workitem_id_x(); asm volatile("" : "+v"(t)); return t; }
DI unsigned pack2(float a, float b) {
  f2_t v = {a, b};
  bf2_t r = __builtin_convertvector(v, bf2_t);
  return __builtin_bit_cast(unsigned, r);
}
DI u16 f2bf(float a) { return (u16)(pack2(a, 0.f) & 0xffffu); }
DI float bf2f(u16 v) { return __uint_as_float(((unsigned)v) << 16); }
DI float bflo(unsigned v) { return __uint_as_float(v << 16); }
DI float bfhi(unsigned v) { return __uint_as_float(v & 0xffff0000u); }
DI float wave_sum(float v) {
#pragma unroll
  for (int o = 32; o > 0; o >>= 1) v += __shfl_xor(v, o, 64);
  return v;
}
DI int crow(int i, int hh) { return (i & 3) + 8 * (i >> 2) + 4 * hh; }
DI int permq(int s) {
  int qd = (s >> 2) & 3;
  int nq = ((qd & 1) << 1) | (qd >> 1);
  return (s & ~15) | (nq << 2);
}
DI void sincos_pos(int pos, double invf, float& c, float& s) {
  double rev = (double)pos * invf * 0.15915494309189535;
  rev -= floor(rev);
  float rf = (float)rev;
  s = __builtin_amdgcn_sinf(rf);
  c = __builtin_amdgcn_cosf(rf);
}
DI float sigmoidf_(float x) { return __builtin_amdgcn_rcpf(1.f + __expf(-x)); }
DI f32x16 zero16() {
  f32x16 z;
#pragma unroll
  for (int i = 0; i < 16; ++i) z[i] = 0.f;
  return z;
}
#define MFMA(a, b, c) __builtin_amdgcn_mfma_f32_32x32x16_bf16((a), (b), (c), 0, 0, 0)

#define WAIT_V0() asm volatile("s_waitcnt vmcnt(0)" ::: "memory")
template <int WN>
DI int gemm_acc_chain(const u16* __restrict__ A, int lda, const u16* __restrict__ Bt, int ldb, int K, f32x16 (&acc)[4][WN], char* lds, int pre,
                      const u16* nA, int nlda, const u16* nBt, int nldb) {
  constexpr int STAGE = 65536;
  constexpr int NBI = 2 * WN;
  const int tid = otid(), lane = tid & 63, w = tid >> 6, r = lane & 31, hh = lane >> 5, wm = w >> 2, wn = w & 3;
  const int srow = 8 * w + (lane >> 3);
  const int sc = (lane & 7) ^ ((srow >> 1) & 7);
  const int nk = K >> 6;
  auto stage = [&](const u16* A_, int lda_, const u16* Bt_, int ldb_, int buf, int k0) {
    char* sa = lds + buf * STAGE + w * 1024;
    const unsigned aoff = (unsigned)(srow * lda_ + sc * 8) * 2u;
    const unsigned boff = (unsigned)(srow * ldb_ + sc * 8) * 2u;
#pragma unroll
    for (int i = 0; i < 4; ++i)
      __builtin_amdgcn_global_load_lds((const unsigned*)((const char*)A_ + (aoff + (unsigned)((64 * i) * lda_ + k0) * 2u)), (unsigned*)(sa + i * 8192), 16, 0, 0);
#pragma unroll
    for (int i = 0; i < NBI; ++i)
      __builtin_amdgcn_global_load_lds((const unsigned*)((const char*)Bt_ + (boff + (unsigned)((64 * i) * ldb_ + k0) * 2u)), (unsigned*)(sa + 32768 + i * 8192), 16, 0, 0);
  };
  const int base = pre >= 0 ? pre : 0;
  if (pre < 0) {
    stage(A, lda, Bt, ldb, 0, 0);
    WAIT_V0();
    __syncthreads();
  }
  for (int kt = 0; kt < nk; ++kt) {
    const int buf = (base + kt) & 1;
    const char* st = lds + buf * STAGE;
    if (kt + 1 < nk) stage(A, lda, Bt, ldb, buf ^ 1, (kt + 1) << 6);
    else if (nA) stage(nA, nlda, nBt, nldb, buf ^ 1, 0);
#pragma unroll
    for (int s = 0; s < 4; ++s) {
      const int chunk = 2 * s + hh;
      bf16x8 a[4], b[WN];
#pragma unroll
      for (int mi = 0; mi < 4; ++mi) {
        const int row = 128 * wm + 32 * mi + r;
        a[mi] = *(const bf16x8*)(st + row * 128 + ((chunk ^ ((row >> 1) & 7)) << 4));
      }
#pragma unroll
      for (int ni = 0; ni < WN; ++ni) {
        const int row = 32 * WN * wn + 32 * ni + r;
        b[ni] = *(const bf16x8*)(st + 32768 + row * 128 + ((chunk ^ ((row >> 1) & 7)) << 4));
      }
#pragma unroll
      for (int mi = 0; mi < 4; ++mi)
#pragma unroll
        for (int ni = 0; ni < WN; ++ni) acc[mi][ni] = MFMA(a[mi], b[ni], acc[mi][ni]);
    }
    WAIT_V0();
    __syncthreads();
  }
  return (base + nk) & 1;
}
template <int WN>
DI void gemm_acc(const u16* __restrict__ A, int lda, const u16* __restrict__ Bt, int ldb, int K, f32x16 (&acc)[4][WN], char* lds) {
  (void)gemm_acc_chain<WN>(A, lda, Bt, ldb, K, acc, lds, -1, nullptr, 0, nullptr, 0);
}


typedef float f32x4m __attribute__((ext_vector_type(4)));
DI int g8_lds_byte(int r, int c) {
  const int st = (r >> 4) * 2 + (c >> 5), rr = r & 15, cc = c & 31, ob = rr * 64 + cc * 2;
  return st * 1024 + (ob ^ (((ob >> 9) & 1) << 5));
}
DI void gemm8_prologue(const u16* __restrict__ A, int lda, const u16* __restrict__ Bt, int ldb, char* lds) {
  constexpr int HTB = 16384;
  const int tid = otid();
  char* const sbase = lds + tid * 16;
#pragma unroll
  for (int h = 0; h < 2; ++h) {
#pragma unroll
    for (int i = 0; i < 2; ++i) {
      const int b = tid * 16 + i * 8192;
      const int st = b >> 10, sb = b & 1023, swz = sb ^ (((sb >> 9) & 1) << 5);
      const int R = (st >> 1) * 16 + (swz >> 6) + h * 128, C = (st & 1) * 32 + ((swz & 63) >> 1);
      __builtin_amdgcn_global_load_lds((const unsigned*)((const char*)Bt + (unsigned)(R * ldb + C) * 2u), (unsigned*)(sbase + (4 + h) * HTB + i * 8192), 16, 0, 0);
    }
#pragma unroll
    for (int i = 0; i < 2; ++i) {
      const int b = tid * 16 + i * 8192;
      const int st = b >> 10, sb = b & 1023, swz = sb ^ (((sb >> 9) & 1) << 5);
      const int R = (st >> 1) * 16 + (swz >> 6) + h * 128, C = (st & 1) * 32 + ((swz & 63) >> 1);
      __builtin_amdgcn_global_load_lds((const unsigned*)((const char*)A + (unsigned)(R * lda + C) * 2u), (unsigned*)(sbase + h * HTB + i * 8192), 16, 0, 0);
    }
  }
}
DI void gemm8_acc(const u16* __restrict__ A, int lda, const u16* __restrict__ Bt, int ldb, int K, f32x4m (&acc)[2][2][4][2], char* lds, bool pre = false) {
  constexpr int HTB = 16384;
  const int tid = otid(), wid = tid >> 6, lane = tid & 63, wr = wid >> 2, wc = wid & 3, fr = lane & 15, fq = lane >> 4;
  unsigned oa[2], ob_[2];
#pragma unroll
  for (int i = 0; i < 2; ++i) {
    const int b = tid * 16 + i * 8192;
    const int st = b >> 10, sb = b & 1023, swz = sb ^ (((sb >> 9) & 1) << 5);
    const int R = (st >> 1) * 16 + (swz >> 6), C = (st & 1) * 32 + ((swz & 63) >> 1);
    oa[i] = (unsigned)(R * lda + C) * 2u;
    ob_[i] = (unsigned)(R * ldb + C) * 2u;
  }
  char* const sbase = lds + tid * 16;
#define G8_SA(b, h) (lds + ((b) * 2 + (h)) * HTB)
#define G8_SB(b, h) (lds + (4 + (b) * 2 + (h)) * HTB)
#define G8_STAGE_A(b, h, kt) do { _Pragma("unroll") for (int _i = 0; _i < 2; ++_i) \
    __builtin_amdgcn_global_load_lds((const unsigned*)((const char*)A + (oa[_i] + (unsigned)((h) * 128 * lda + (kt) * 64) * 2u)), \
                                     (unsigned*)(sbase + ((b) * 2 + (h)) * HTB + _i * 8192), 16, 0, 0); } while (0)
#define G8_STAGE_B(b, h, kt) do { _Pragma("unroll") for (int _i = 0; _i < 2; ++_i) \
    __builtin_amdgcn_global_load_lds((const unsigned*)((const char*)Bt + (ob_[_i] + (unsigned)((h) * 128 * ldb + (kt) * 64) * 2u)), \
                                     (unsigned*)(sbase + (4 + (b) * 2 + (h)) * HTB + _i * 8192), 16, 0, 0); } while (0)
#define G8_LDA(dst, b, h) do { _Pragma("unroll") for (int m = 0; m < 4; ++m) _Pragma("unroll") for (int k = 0; k < 2; ++k) \
    dst[m][k] = *(const bf16x8*)(G8_SA(b, h) + g8_lds_byte(wr * 64 + m * 16 + fr, k * 32 + fq * 8)); } while (0)
#define G8_LDB(dst, b, h) do { _Pragma("unroll") for (int n = 0; n < 2; ++n) _Pragma("unroll") for (int k = 0; k < 2; ++k) \
    dst[n][k] = *(const bf16x8*)(G8_SB(b, h) + g8_lds_byte(wc * 32 + n * 16 + fr, k * 32 + fq * 8)); } while (0)
#define G8_MMA(ai, bj, At_, Bt_) do { __builtin_amdgcn_s_setprio(1); \
    _Pragma("unroll") for (int m = 0; m < 4; ++m) _Pragma("unroll") for (int n = 0; n < 2; ++n) _Pragma("unroll") for (int k = 0; k < 2; ++k) \
      acc[ai][bj][m][n] = __builtin_amdgcn_mfma_f32_16x16x32_bf16(At_[m][k], Bt_[n][k], acc[ai][bj][m][n], 0, 0, 0); \
    __builtin_amdgcn_s_setprio(0); } while (0)
#define G8_WV(n) asm volatile("s_waitcnt vmcnt(" #n ")" ::: "memory")
#define G8_WL(n) asm volatile("s_waitcnt lgkmcnt(" #n ")" ::: "memory")
#define G8_BAR __builtin_amdgcn_s_barrier()
#define G8_SCHED __builtin_amdgcn_sched_barrier(0)
  bf16x8 At[4][2], B0[2][2], B1[2][2];
  const int nt = K >> 6;
  if (!pre) { G8_STAGE_B(0, 0, 0); G8_STAGE_A(0, 0, 0); G8_STAGE_B(0, 1, 0); G8_STAGE_A(0, 1, 0); }
  if (wr == 1) G8_BAR;
  G8_WV(4); G8_BAR;
  G8_STAGE_B(1, 0, 1); G8_STAGE_A(1, 0, 1); G8_STAGE_B(1, 1, 1);
  G8_WV(6); G8_BAR;
  for (int t = 0; t < nt - 2; t += 2) {
    G8_LDB(B0, 0, 0); G8_SCHED; G8_LDA(At, 0, 0); G8_STAGE_A(1, 1, t + 1);
    G8_WL(8); G8_BAR; G8_WL(0); G8_MMA(0, 0, At, B0); G8_BAR; G8_SCHED;
    G8_LDB(B1, 0, 1); G8_STAGE_B(0, 0, t + 2);
    G8_BAR; G8_WL(0); G8_MMA(0, 1, At, B1); G8_BAR;
    G8_LDA(At, 0, 1); G8_STAGE_A(0, 0, t + 2);
    G8_BAR; G8_WL(0); G8_MMA(1, 0, At, B0); G8_BAR; G8_SCHED;
    G8_STAGE_B(0, 1, t + 2);
    G8_WV(6); G8_BAR; G8_MMA(1, 1, At, B1); G8_BAR;
    G8_LDB(B0, 1, 0); G8_SCHED; G8_LDA(At, 1, 0); G8_STAGE_A(0, 1, t + 2);
    G8_WL(8); G8_BAR; G8_WL(0); G8_MMA(0, 0, At, B0); G8_BAR; G8_SCHED;
    G8_LDB(B1, 1, 1); G8_STAGE_B(1, 0, t + 3);
    G8_BAR; G8_WL(0); G8_MMA(0, 1, At, B1); G8_BAR;
    G8_LDA(At, 1, 1); G8_STAGE_A(1, 0, t + 3);
    G8_BAR; G8_WL(0); G8_MMA(1, 0, At, B0); G8_BAR; G8_SCHED;
    G8_STAGE_B(1, 1, t + 3);
    G8_WV(6); G8_BAR; G8_MMA(1, 1, At, B1); G8_BAR;
  }
  {
    G8_LDB(B0, 0, 0); G8_LDA(At, 0, 0); G8_STAGE_A(1, 1, nt - 1);
    G8_BAR; G8_WL(0); G8_MMA(0, 0, At, B0); G8_BAR;
    G8_LDB(B1, 0, 1); G8_BAR; G8_WL(0); G8_MMA(0, 1, At, B1); G8_BAR;
    G8_LDA(At, 0, 1); G8_WV(4); G8_BAR; G8_WL(0); G8_MMA(1, 0, At, B0); G8_MMA(1, 1, At, B1); G8_BAR;
  }
  {
    G8_LDB(B0, 1, 0); G8_LDA(At, 1, 0); G8_WV(2); G8_BAR; G8_WL(0); G8_MMA(0, 0, At, B0); G8_BAR;
    G8_LDB(B1, 1, 1); G8_WV(0); G8_BAR; G8_WL(0); G8_MMA(0, 1, At, B1); G8_BAR;
    G8_LDA(At, 1, 1); G8_BAR; G8_WL(0); G8_MMA(1, 0, At, B0); G8_MMA(1, 1, At, B1); G8_BAR;
  }
  if (wr == 0) G8_BAR;
}
template <class F>
DI void epi8_apply(f32x4m (&acc)[2][2][4][2], int m0, int n0, F f) {
  const int tid = otid(), wid = tid >> 6, lane = tid & 63, wr = wid >> 2, wc = wid & 3, fr = lane & 15, fq = lane >> 4;
#pragma unroll
  for (int ai = 0; ai < 2; ++ai)
#pragma unroll
    for (int bj = 0; bj < 2; ++bj)
#pragma unroll
      for (int m = 0; m < 4; ++m)
#pragma unroll
        for (int n = 0; n < 2; ++n) {
          const f32x4m v = acc[ai][bj][m][n];
          f(m0 + ai * 128 + wr * 64 + m * 16 + fq * 4, n0 + bj * 128 + wc * 32 + n * 16 + fr, v[0], v[1], v[2], v[3]);
        }
}
DI void zero_acc8(f32x4m (&acc)[2][2][4][2]) {
#pragma unroll
  for (int ai = 0; ai < 2; ++ai)
#pragma unroll
    for (int bj = 0; bj < 2; ++bj)
#pragma unroll
      for (int m = 0; m < 4; ++m)
#pragma unroll
        for (int n = 0; n < 2; ++n) { f32x4m z = {0.f, 0.f, 0.f, 0.f}; acc[ai][bj][m][n] = z; }
}

template <int WN>
DI void zero_acc(f32x16 (&acc)[4][WN]) {
#pragma unroll
  for (int mi = 0; mi < 4; ++mi)
#pragma unroll
    for (int ni = 0; ni < WN; ++ni) acc[mi][ni] = zero16();
}

template <int WN, class F>
DI void epi_apply(f32x16 (&acc)[4][WN], int m0, int n0, F f) {
  const int tid = otid(), lane = tid & 63, w = tid >> 6, r = lane & 31, hh = lane >> 5, wm = w >> 2, wn = w & 3;
#pragma unroll
  for (int mi = 0; mi < 4; ++mi)
#pragma unroll
    for (int ni = 0; ni < WN; ++ni)
#pragma unroll
      for (int g4 = 0; g4 < 4; ++g4) {
        const int m = m0 + 128 * wm + 32 * mi + 8 * g4 + 4 * hh;
        const int n = n0 + 32 * WN * wn + 32 * ni + r;
        f(m, n, acc[mi][ni][4 * g4], acc[mi][ni][4 * g4 + 1], acc[mi][ni][4 * g4 + 2], acc[mi][ni][4 * g4 + 3]);
      }
}

DI void store_rows(u16* dst, size_t ld, int m, int n, float v0, float v1, float v2, float v3) {
  u16* q = dst + (size_t)m * ld + n;
  q[0] = f2bf(v0);
  q[ld] = f2bf(v1);
  q[2 * ld] = f2bf(v2);
  q[3 * ld] = f2bf(v3);
}
DI void store_quad(u16* dst, float v0, float v1, float v2, float v3) {
  u32x2 u;
  u.x = pack2(v0, v1);
  u.y = pack2(v2, v3);
  *(u32x2*)dst = u;
}

template <int R>
DI void rowpass(const float* xs, float* xd, const u16* o, const float* gpost, const float* gnext, u16* hd, int row0, int stride, int lane) {
  float xv[R][16];
  float ov[R][16];
#pragma unroll
  for (int k = 0; k < R; ++k) {
    const float* xr = xs + (size_t)(row0 + k * stride) * 1024;
#pragma unroll
    for (int i = 0; i < 4; ++i) {
      f32x4 v = __builtin_nontemporal_load((const f32x4*)(xr + lane * 4 + 256 * i));
      xv[k][4 * i] = v.x; xv[k][4 * i + 1] = v.y; xv[k][4 * i + 2] = v.z; xv[k][4 * i + 3] = v.w;
    }
  }
  if (o) {
#pragma unroll
    for (int k = 0; k < R; ++k) {
      const u16* orow = o + (size_t)(row0 + k * stride) * 1024;
#pragma unroll
      for (int i = 0; i < 4; ++i) {
        u32x2 u = __builtin_nontemporal_load((const u32x2*)(orow + lane * 4 + 256 * i));
        ov[k][4 * i] = bflo(u.x); ov[k][4 * i + 1] = bfhi(u.x); ov[k][4 * i + 2] = bflo(u.y); ov[k][4 * i + 3] = bfhi(u.y);
      }
    }
    float gp[16];
#pragma unroll
    for (int i = 0; i < 4; ++i) {
      f32x4 g = *(const f32x4*)(gpost + lane * 4 + 256 * i);
      gp[4 * i] = g.x; gp[4 * i + 1] = g.y; gp[4 * i + 2] = g.z; gp[4 * i + 3] = g.w;
    }
    float ss[R];
#pragma unroll
    for (int k = 0; k < R; ++k) {
      ss[k] = 0.f;
#pragma unroll
      for (int i = 0; i < 16; ++i) ss[k] += ov[k][i] * ov[k][i];
    }
#pragma unroll
    for (int off = 32; off > 0; off >>= 1)
#pragma unroll
      for (int k = 0; k < R; ++k) ss[k] += __shfl_xor(ss[k], off, 64);
#pragma unroll
    for (int k = 0; k < R; ++k) {
      const float rs = rsqrtf(ss[k] * (1.f / 1024.f) + 1e-6f);
#pragma unroll
      for (int i = 0; i < 16; ++i) xv[k][i] += ov[k][i] * rs * gp[i];
      float* xw = xd + (size_t)(row0 + k * stride) * 1024;
#pragma unroll
      for (int i = 0; i < 4; ++i) __builtin_nontemporal_store(mk_f4(xv[k][4 * i], xv[k][4 * i + 1], xv[k][4 * i + 2], xv[k][4 * i + 3]), (f32x4*)(xw + lane * 4 + 256 * i));
    }
  }
  if (gnext) {
    float gn[16];
#pragma unroll
    for (int i = 0; i < 4; ++i) {
      f32x4 g = *(const f32x4*)(gnext + lane * 4 + 256 * i);
      gn[4 * i] = g.x; gn[4 * i + 1] = g.y; gn[4 * i + 2] = g.z; gn[4 * i + 3] = g.w;
    }
    float ss[R];
#pragma unroll
    for (int k = 0; k < R; ++k) {
      ss[k] = 0.f;
#pragma unroll
      for (int i = 0; i < 16; ++i) ss[k] += xv[k][i] * xv[k][i];
    }
#pragma unroll
    for (int off = 32; off > 0; off >>= 1)
#pragma unroll
      for (int k = 0; k < R; ++k) ss[k] += __shfl_xor(ss[k], off, 64);
#pragma unroll
    for (int k = 0; k < R; ++k) {
      const float rs = rsqrtf(ss[k] * (1.f / 1024.f) + 1e-6f);
      u16* hw = hd + (size_t)(row0 + k * stride) * 1024;
#pragma unroll
      for (int i = 0; i < 4; ++i) {
        u32x2 u;
        u.x = pack2(xv[k][4 * i] * rs * gn[4 * i], xv[k][4 * i + 1] * rs * gn[4 * i + 1]);
        u.y = pack2(xv[k][4 * i + 2] * rs * gn[4 * i + 2], xv[k][4 * i + 3] * rs * gn[4 * i + 3]);
        *(u32x2*)(hw + lane * 4 + 256 * i) = u;
      }
    }
  }
}
DI void rowpass_all(const float* xs, float* xd, const u16* o, const float* gpost, const float* gnext, u16* hd) {
  const int lane = otid() & 63, gw = blockIdx.x * 8 + (otid() >> 6), nw = gridDim.x * 8;
  int row = gw;
  for (; row + 3 * nw < T; row += 4 * nw) rowpass<4>(xs, xd, o, gpost, gnext, hd, row, nw, lane);
  for (; row < T; row += nw) rowpass<1>(xs, xd, o, gpost, gnext, hd, row, nw, lane);
}

DI void transpose_job(const float* __restrict__ src, u16* __restrict__ dst, int K, int N, int Npad, char* lds) {
  float* sm = (float*)lds;
  const int tid = otid();
  const int ktiles = K >> 6;
  const int ntiles = (Npad >> 6) * ktiles;
  for (int tile = blockIdx.x; tile < ntiles; tile += gridDim.x) {
    const int kt = tile % ktiles, nt = tile / ktiles;
    const int k0 = kt << 6, n0 = nt << 6;
    const int nl = tid & 63;
#pragma unroll
    for (int i = 0; i < 8; ++i) {
      const int kk = (tid >> 6) + 8 * i;
      const int n = n0 + nl;
      float v = (n < N) ? __builtin_nontemporal_load(src + (size_t)(k0 + kk) * N + n) : 0.f;
      sm[kk * 65 + nl] = v;
    }
    __syncthreads();
    const int nr = tid >> 3, seg = tid & 7;
    unsigned u[4];
#pragma unroll
    for (int j = 0; j < 4; ++j) u[j] = pack2(sm[(seg * 8 + 2 * j) * 65 + nr], sm[(seg * 8 + 2 * j + 1) * 65 + nr]);
    u16* d = dst + (size_t)(n0 + nr) * K + k0 + seg * 8;
    *(u32x4*)d = mk_u4(u[0], u[1], u[2], u[3]);
    __syncthreads();
  }
}

DI void phase0(const Params& p, char* lds) {
  u16* wbase = (u16*)wsp(p);
  for (int l = 0; l < 2; ++l) {
    u16* wl = wbase + (size_t)l * W_LAYER;
    transpose_job((const float*)inp(p, 4) + (size_t)l * 1024 * 6584, wl + W_IN, 1024, 6584, 6656, lds);
    transpose_job((const float*)inp(p, 7) + (size_t)l * 384 * 768, wl + W_UQ, 384, 768, 768, lds);
    transpose_job((const float*)inp(p, 9) + (size_t)l * 256 * 1024, wl + W_UKV, 256, 1024, 1024, lds);
    transpose_job((const float*)inp(p, 12) + (size_t)l * 2048 * 64, wl + W_CK, 2048, 64, 64, lds);
    transpose_job((const float*)inp(p, 13) + (size_t)l * 2048 * 64, wl + W_CV, 2048, 64, 64, lds);
    transpose_job((const float*)inp(p, 14) + (size_t)l * 512 * 1024, wl + W_BC, 512, 1024, 1024, lds);
    transpose_job((const float*)inp(p, 15) + (size_t)l * 512 * 1024, wl + W_BM, 512, 1024, 1024, lds);
    transpose_job((const float*)inp(p, 16) + (size_t)l * 512 * 1024, wl + W_BN, 512, 1024, 1024, lds);
    transpose_job((const float*)inp(p, 17) + (size_t)l * 1024 * 1024, wl + W_OUT, 1024, 1024, 1024, lds);
    transpose_job((const float*)inp(p, 20) + (size_t)l * 1024 * 5632, wl + W_UP, 1024, 5632, 5632, lds);
    transpose_job((const float*)inp(p, 23) + (size_t)l * 2816 * 1024, wl + W_DOWN, 2816, 1024, 1024, lds);
  }
  const int lane = otid() & 63, gw = blockIdx.x * 8 + (otid() >> 6), nw = gridDim.x * 8;
  float* bias = (float*)(wsp(p) + OFF_BIAS);
  for (int oi = gw; oi < 256; oi += nw) {
    const int l = oi >> 7, kv = (oi >> 6) & 1, e = oi & 63;
    const float* pos = (const float*)p.in[kv ? 11 : 10] + (size_t)l * 2048;
    const float* wt = (const float*)p.in[kv ? 13 : 12] + (size_t)l * 2048 * 64;
    float s = 0.f;
    for (int idx = lane; idx < 2048; idx += 64) s += pos[idx] * wt[(size_t)idx * 64 + e];
    s = wave_sum(s);
    if (lane == 0) bias[oi] = s;
  }
  rowpass_all((const float*)inp(p, 0), nullptr, nullptr, nullptr, (const float*)inp(p, 2), (u16*)(wsp(p) + OFF_H));
}


DI bool tile_mn(int j, int NT, int total, int& mt, int& nt) {
  const int i = blockIdx.x;
  const int lin = j * gridDim.x + (i & 7) * (gridDim.x >> 3) + (i >> 3);
  if (lin >= total) return false;
  mt = 4 * (lin / (4 * NT)) + (lin & 3);
  nt = (lin >> 2) % NT;
  return true;
}

DI void phaseA(const Params& p, int l, char* lds) {
  const u16* h = (const u16*)(wsp(p) + OFF_H);
  const u16* wt = (const u16*)wsp(p) + (size_t)l * W_LAYER + W_IN + (size_t)3072 * 1024;
  char* ws = wsp(p);
  bool pre = false;
  for (int j = 0; j * (int)gridDim.x < 128 * 14; ++j) {
    int mt, nt;
    if (!tile_mn(j, 14, 128 * 14, mt, nt)) continue;
    const int m0 = mt * 256, n0 = nt * 256;
    int mt2 = 0, nt2 = 0;
    const bool has_next = ((j + 1) * (int)gridDim.x < 128 * 14) && tile_mn(j + 1, 14, 128 * 14, mt2, nt2);
    f32x4m acc[2][2][4][2];
    zero_acc8(acc);
    gemm8_acc(h + (size_t)m0 * 1024, 1024, wt + (size_t)n0 * 1024, 1024, 1024, acc, lds, pre);
    if (has_next) gemm8_prologue(h + (size_t)(mt2 * 256) * 1024, 1024, wt + (size_t)(nt2 * 256) * 1024, 1024, lds);
    pre = has_next;
    epi8_apply(acc, m0, n0, [&](int m, int n, float v0, float v1, float v2, float v3) {
      const int b = m >> 13, s = m & (S - 1);
      if (n < 1536) {
        store_rows((u16*)(ws + OFF_P1A), 1536, m, n, v0, v1, v2, v3);
      } else if (n < 2208) {
        store_rows((u16*)(ws + OFF_P1B), 672, m, n - 1536, v0, v1, v2, v3);
      } else if (n < 2720) {
        const int c = n - 2208, hd = c >> 6, d = c & 63;
        store_rows((u16*)(ws + OFF_QN) + (size_t)(b * 8 + hd) * S * 64, 64, s, d, v0, v1, v2, v3);
      } else if (n < 3488) {
        const int seg = (n - 2720) >> 7;
        const int c = (n - 2720) & 127, g = c >> 6, d = c & 63;
        if (seg == 3 || seg == 5) {
          u16* dst = (u16*)(ws + (seg == 3 ? OFF_VST : OFF_VWT)) + ((size_t)((b * 2 + g) * 64 + d)) * S + permq(s);
          store_quad(dst, v0, v1, v2, v3);
        } else {
          const size_t off = seg == 0 ? OFF_KCMP : seg == 1 ? OFF_VCMP : seg == 2 ? OFF_KSLC : OFF_KWIN;
          store_rows((u16*)(ws + off) + (size_t)(b * 2 + g) * S * 64, 64, s, d, v0, v1, v2, v3);
        }
      } else if (n < N1) {
        float* gp = (float*)(ws + OFF_G) + (size_t)m * 24 + (n - 3488);
        gp[0] = v0; gp[24] = v1; gp[48] = v2; gp[72] = v3;
      }
    });
  }
}

struct TokRegs {
  u32x4 uc, ux, ub;
  unsigned cq[3];
  u32x2 ckv;
  int pos;
  u16 q1, q2, k1, k2, r1, r2;
};
DI void phaseB(const Params& p, int l) {
  const int lane = otid() & 63, gw = blockIdx.x * 8 + (otid() >> 6), nw = gridDim.x * 8;
  char* ws = wsp(p);
  const u16* P1A = (const u16*)(ws + OFF_P1A);
  u16* P1B = (u16*)(ws + OFF_P1B);
  const float* cw = (const float*)inp(p, 5) + (size_t)l * 3 * 512;
  const float* qn = (const float*)inp(p, 6) + (size_t)l * 384;
  const float* kvn = (const float*)inp(p, 8) + (size_t)l * 256;
  const int* posp = (const int*)inp(p, 1);
  const int c0 = lane * 8;
  float w[3][8];
#pragma unroll
  for (int k = 0; k < 3; ++k) {
    const f32x4 x0 = *(const f32x4*)(cw + k * 512 + c0), x1 = *(const f32x4*)(cw + k * 512 + c0 + 4);
    w[k][0] = x0.x; w[k][1] = x0.y; w[k][2] = x0.z; w[k][3] = x0.w; w[k][4] = x1.x; w[k][5] = x1.y; w[k][6] = x1.z; w[k][7] = x1.w;
  }
  float gq[6];
#pragma unroll
  for (int i = 0; i < 3; ++i) { gq[2 * i] = qn[lane * 2 + 128 * i]; gq[2 * i + 1] = qn[lane * 2 + 128 * i + 1]; }
  const f32x4 gkv = *(const f32x4*)(kvn + lane * 4);
  const int ri = lane & 7;
  const int ktn = lane >> 4, kg = (lane >> 3) & 1;
  const size_t koffb = ktn == 0 ? OFF_KCMP : ktn == 1 ? OFF_KSLC : OFF_KWIN;
  auto qptr = [&](int b, int s) { return (u16*)(ws + OFF_QN) + ((size_t)(b * 8 + (lane >> 3)) * S + s) * 64 + ri; };
  auto kptr = [&](int b, int s) { return (u16*)(ws + koffb) + ((size_t)(b * 2 + kg) * S + s) * 64 + ri; };
  auto loads = [&](int t, TokRegs& g) {
    const int b = t >> 13, s = t & (S - 1);
    const u16* row = P1A + (size_t)t * 1536;
    g.ub = __builtin_nontemporal_load((const u32x4*)(row + c0));
    g.uc = __builtin_nontemporal_load((const u32x4*)(row + 512 + c0));
    g.ux = __builtin_nontemporal_load((const u32x4*)(row + 1024 + c0));
    const u16* pb = P1B + (size_t)t * 672;
#pragma unroll
    for (int i = 0; i < 3; ++i) g.cq[i] = *(const unsigned*)(pb + lane * 2 + 128 * i);
    g.ckv = *(const u32x2*)(pb + 384 + lane * 4);
    g.pos = posp[t];
    const u16* q = qptr(b, s);
    g.q1 = q[0]; g.q2 = q[8];
    g.k1 = 0; g.k2 = 0; g.r1 = 0; g.r2 = 0;
    if (lane < 48) { const u16* k = kptr(b, s); g.k1 = k[0]; g.k2 = k[8]; }
    if (lane < 16) { g.r1 = pb[640 + lane]; g.r2 = pb[656 + lane]; }
  };
  constexpr int RUN = 16;
  for (int run = gw; run < T / RUN; run += nw) {
    const int t0 = run * RUN, s0 = t0 & (S - 1);
    float um2[8], um1[8];
#pragma unroll
    for (int j = 0; j < 8; ++j) { um2[j] = 0.f; um1[j] = 0.f; }
    if (s0 > 0) {
      const u16* r2 = P1A + (size_t)(t0 - 2) * 1536;
      const u16* r1 = P1A + (size_t)(t0 - 1) * 1536;
      const u32x4 c2 = *(const u32x4*)(r2 + 512 + c0), x2 = *(const u32x4*)(r2 + 1024 + c0);
      const u32x4 c1 = *(const u32x4*)(r1 + 512 + c0), x1 = *(const u32x4*)(r1 + 1024 + c0);
      um2[0] = bflo(c2.x) * bflo(x2.x); um2[1] = bfhi(c2.x) * bfhi(x2.x); um2[2] = bflo(c2.y) * bflo(x2.y); um2[3] = bfhi(c2.y) * bfhi(x2.y);
      um2[4] = bflo(c2.z) * bflo(x2.z); um2[5] = bfhi(c2.z) * bfhi(x2.z); um2[6] = bflo(c2.w) * bflo(x2.w); um2[7] = bfhi(c2.w) * bfhi(x2.w);
      um1[0] = bflo(c1.x) * bflo(x1.x); um1[1] = bfhi(c1.x) * bfhi(x1.x); um1[2] = bflo(c1.y) * bflo(x1.y); um1[3] = bfhi(c1.y) * bfhi(x1.y);
      um1[4] = bflo(c1.z) * bflo(x1.z); um1[5] = bfhi(c1.z) * bfhi(x1.z); um1[6] = bflo(c1.w) * bflo(x1.w); um1[7] = bfhi(c1.w) * bfhi(x1.w);
    }
    TokRegs cur, nxt;
    loads(t0, cur);
    for (int tt = 0; tt < RUN; ++tt) {
      const int t = t0 + tt, b = t >> 13, s = t & (S - 1);
      if (tt + 1 < RUN) loads(t + 1, nxt);
      {
        const float cc[8] = {bflo(cur.uc.x), bfhi(cur.uc.x), bflo(cur.uc.y), bfhi(cur.uc.y), bflo(cur.uc.z), bfhi(cur.uc.z), bflo(cur.uc.w), bfhi(cur.uc.w)};
        const float cx[8] = {bflo(cur.ux.x), bfhi(cur.ux.x), bflo(cur.ux.y), bfhi(cur.ux.y), bflo(cur.ux.z), bfhi(cur.ux.z), bflo(cur.ux.w), bfhi(cur.ux.w)};
        const float cb[8] = {bflo(cur.ub.x), bfhi(cur.ub.x), bflo(cur.ub.y), bfhi(cur.ub.y), bflo(cur.ub.z), bfhi(cur.ub.z), bflo(cur.ub.w), bfhi(cur.ub.w)};
        float y[8];
#pragma unroll
        for (int j = 0; j < 8; ++j) {
          const float u0 = cc[j] * cx[j];
          y[j] = cb[j] * (w[0][j] * um2[j] + w[1][j] * um1[j] + w[2][j] * u0);
          um2[j] = um1[j];
          um1[j] = u0;
        }
        *(u32x4*)((u16*)(ws + OFF_YCONV) + (size_t)t * 512 + c0) = mk_u4(pack2(y[0], y[1]), pack2(y[2], y[3]), pack2(y[4], y[5]), pack2(y[6], y[7]));
      }
      u16* pb = P1B + (size_t)t * 672;
      {
        float v[6];
#pragma unroll
        for (int i = 0; i < 3; ++i) { v[2 * i] = bflo(cur.cq[i]); v[2 * i + 1] = bfhi(cur.cq[i]); }
        const float k0 = bflo(cur.ckv.x), k1 = bfhi(cur.ckv.x), k2 = bflo(cur.ckv.y), k3 = bfhi(cur.ckv.y);
        float s1 = v[0] * v[0] + v[1] * v[1] + v[2] * v[2] + v[3] * v[3] + v[4] * v[4] + v[5] * v[5];
        float s2 = k0 * k0 + k1 * k1 + k2 * k2 + k3 * k3;
#pragma unroll
        for (int off = 32; off > 0; off >>= 1) { s1 += __shfl_xor(s1, off, 64); s2 += __shfl_xor(s2, off, 64); }
        const float rs1 = rsqrtf(s1 * (1.f / 384.f) + 1e-6f), rs2 = rsqrtf(s2 * (1.f / 256.f) + 1e-6f);
#pragma unroll
        for (int i = 0; i < 3; ++i) *(unsigned*)(pb + lane * 2 + 128 * i) = pack2(v[2 * i] * rs1 * gq[2 * i], v[2 * i + 1] * rs1 * gq[2 * i + 1]);
        u32x2 o;
        o.x = pack2(k0 * rs2 * gkv.x, k1 * rs2 * gkv.y);
        o.y = pack2(k2 * rs2 * gkv.z, k3 * rs2 * gkv.w);
        *(u32x2*)(pb + 384 + lane * 4) = o;
      }
      {
        float c, sn;
        sincos_pos(cur.pos, INVF[2 * ri], c, sn);
        {
          u16* q = qptr(b, s);
          const float x1 = bf2f(cur.q1), x2 = bf2f(cur.q2);
          q[0] = f2bf(x1 * c - x2 * sn);
          q[8] = f2bf(x2 * c + x1 * sn);
        }
        if (lane < 48) {
          u16* k = kptr(b, s);
          const float x1 = bf2f(cur.k1), x2 = bf2f(cur.k2);
          k[0] = f2bf(x1 * c - x2 * sn);
          k[8] = f2bf(x2 * c + x1 * sn);
        }
      }
      if (lane < 16) {
        float c, sn;
        sincos_pos(cur.pos, INVF[lane], c, sn);
        const float x1 = bf2f(cur.r1), x2 = bf2f(cur.r2);
        const u16 r1 = f2bf(x1 * c - x2 * sn), r2 = f2bf(x2 * c + x1 * sn);
#pragma unroll
        for (int hd = 0; hd < 8; ++hd) {
          u16* k = (u16*)(ws + OFF_KMLA) + ((size_t)(b * 8 + hd) * S + s) * 96;
          k[64 + lane] = r1;
          k[80 + lane] = r2;
        }
      }
      cur = nxt;
    }
  }
}

DI void phaseC(const Params& p, int l, char* lds) {
  char* ws = wsp(p);
  const u16* wl = (const u16*)wsp(p) + (size_t)l * W_LAYER;
  const u16* P1B = (const u16*)(wsp(p) + OFF_P1B);
  const float* bias = (const float*)(wsp(p) + OFF_BIAS) + l * 128;
  constexpr int NT_Q = 128 * 6, NT_KV = 128 * 4, NT_C = 32;
  for (int tile0 = blockIdx.x; tile0 < NT_KV + NT_Q + NT_C; tile0 += gridDim.x) {
    const int tile = tile0 < NT_C ? NT_KV + NT_Q + tile0 : tile0 - NT_C;
    if (tile < NT_KV) {
      const int mt = tile >> 2, nt = tile & 3;
      const int m0 = mt * 256, n0 = nt * 256;
      f32x16 acc[4][2];
      zero_acc<2>(acc);
      gemm_acc<2>(P1B + (size_t)m0 * 672 + 384, 672, wl + W_UKV + (size_t)n0 * 256, 256, 256, acc, lds);
      epi_apply<2>(acc, m0, n0, [&](int m, int n, float v0, float v1, float v2, float v3) {
        const int b = m >> 13, s = m & (S - 1), hd = n >> 7, c = n & 127;
        if (c < 64) {
          store_rows((u16*)(ws + OFF_KMLA) + (size_t)(b * 8 + hd) * S * 96, 96, s, c, v0, v1, v2, v3);
        } else {
          u16* dst = (u16*)(ws + OFF_VTMLA) + ((size_t)((b * 8 + hd) * 64 + (c - 64))) * S + permq(s);
          store_quad(dst, v0, v1, v2, v3);
        }
      });
    } else if (tile < NT_KV + NT_Q) {
      const int t2 = tile - NT_KV;
      const int mt = t2 / 6, nt = t2 % 6;
      const int m0 = mt * 256, n0 = nt * 128;
      f32x16 acc[4][1];
      zero_acc<1>(acc);
      gemm_acc<1>(P1B + (size_t)m0 * 672, 672, wl + W_UQ + (size_t)n0 * 384, 384, 384, acc, lds);
      epi_apply<1>(acc, m0, n0, [&](int m, int n, float v0, float v1, float v2, float v3) {
        const int b = m >> 13, s = m & (S - 1), hd = n / 96, c = n % 96;
        store_rows((u16*)(ws + OFF_QMLA) + (size_t)(b * 8 + hd) * S * 96, 96, s, c, v0, v1, v2, v3);
      });
    } else {
      const int t2 = tile - NT_KV - NT_Q;
      const int kv = t2 >> 4, slab = (t2 >> 1) & 7, mt = t2 & 1;
      const u16* Ab = (const u16*)(ws + (kv ? OFF_VCMP : OFF_KCMP)) + (size_t)slab * S * 64 + (size_t)(mt * 256) * 1024;
      f32x16 acc[4][1];
      zero_acc<1>(acc);
      gemm_acc<1>(Ab, 1024, wl + (kv ? W_CV : W_CK), 2048, 2048, acc, lds);
      const float* bs = bias + kv * 64;
      epi_apply<1>(acc, mt * 256, 0, [&](int m, int n, float v0, float v1, float v2, float v3) {
        if (n >= 64) return;
        const float bb = bs[n];
        v0 += bb; v1 += bb; v2 += bb; v3 += bb;
        if (m + 3 >= 511) v3 = 0.f;
        if (kv == 0) {
          store_rows((u16*)(ws + OFF_KC) + (size_t)slab * 512 * 64, 64, m, n, v0, v1, v2, v3);
        } else {
          u16* dst = (u16*)(ws + OFF_VCT) + ((size_t)(slab * 64 + n)) * 512 + permq(m);
          store_quad(dst, v0, v1, v2, v3);
        }
      });
    }
  }
}

constexpr float C_MLA = 0.14724444602590306f;
constexpr float C_NSA = 0.18033688011112042f;

DI bf16x8 pack8(const f32x16& x, int s2) {
  u32x4 u;
  u.x = pack2(x[8 * s2 + 0], x[8 * s2 + 1]);
  u.y = pack2(x[8 * s2 + 2], x[8 * s2 + 3]);
  u.z = pack2(x[8 * s2 + 4], x[8 * s2 + 5]);
  u.w = pack2(x[8 * s2 + 6], x[8 * s2 + 7]);
  return __builtin_bit_cast(bf16x8, u);
}
DI bf16x8 frag128(const char* base, int row, int chunk) { return *(const bf16x8*)(base + row * 128 + ((chunk ^ ((row >> 1) & 7)) << 4)); }
DI bf16x8 frag256(const char* base, int row, int chunk) { return *(const bf16x8*)(base + row * 256 + ((chunk ^ (row & 15)) << 4)); }

template <bool MASKED>
DI void softmax_step(f32x16 (&sc)[2], const float C, float& m, float& lsum, f32x16 (&o)[2], int kbase, int lo, int hi, bool lane_on, int hh,
                     const bf16x8 (&vf)[2][2][2]) {
  float mx;
  if (MASKED) {
    mx = -1e30f;
#pragma unroll
    for (int kb = 0; kb < 2; ++kb)
#pragma unroll
      for (int i = 0; i < 16; ++i) {
        const int key = kbase + 32 * kb + crow(i, hh);
        mx = fmaxf(mx, (key <= hi && key > lo) ? sc[kb][i] : -1e30f);
      }
  } else {
    float a0 = fmaxf(fmaxf(sc[0][0], sc[0][1]), sc[0][2]);
    float a1 = fmaxf(fmaxf(sc[1][0], sc[1][1]), sc[1][2]);
#pragma unroll
    for (int i = 3; i < 15; i += 2) {
      a0 = fmaxf(fmaxf(a0, sc[0][i]), sc[0][i + 1]);
      a1 = fmaxf(fmaxf(a1, sc[1][i]), sc[1][i + 1]);
    }
    mx = fmaxf(fmaxf(a0, a1), fmaxf(sc[0][15], sc[1][15]));
  }
  if (!lane_on) mx = -1e30f;
  mx = fmaxf(mx, __shfl_xor(mx, 32, 64));
  if (__any((mx - m) * C > 8.f)) {
    const float mn = fmaxf(m, mx);
    const float alpha = __builtin_amdgcn_exp2f((m - mn) * C);
    m = mn;
    lsum *= alpha;
    o[0] = o[0] * alpha;
    o[1] = o[1] * alpha;
  }
  const float mc = lane_on ? m * C : 3e38f;
  f32x16 t0 = sc[0] * C - mc;
#pragma unroll
  for (int i = 0; i < 16; ++i) t0[i] = __builtin_amdgcn_exp2f(t0[i]);
  if (MASKED) {
#pragma unroll
    for (int i = 0; i < 16; ++i) {
      const int key0 = kbase + crow(i, hh);
      t0[i] = (key0 <= hi && key0 > lo) ? t0[i] : 0.f;
    }
  }
#pragma unroll
  for (int s2 = 0; s2 < 2; ++s2) {
    const bf16x8 pb = pack8(t0, s2);
#pragma unroll
    for (int dvb = 0; dvb < 2; ++dvb) o[dvb] = MFMA(vf[0][s2][dvb], pb, o[dvb]);
  }
  f32x16 t1 = sc[1] * C - mc;
#pragma unroll
  for (int i = 0; i < 16; ++i) t1[i] = __builtin_amdgcn_exp2f(t1[i]);
  if (MASKED) {
#pragma unroll
    for (int i = 0; i < 16; ++i) {
      const int key1 = kbase + 32 + crow(i, hh);
      t1[i] = (key1 <= hi && key1 > lo) ? t1[i] : 0.f;
    }
  }
#pragma unroll
  for (int s2 = 0; s2 < 2; ++s2) {
    const bf16x8 pb = pack8(t1, s2);
#pragma unroll
    for (int dvb = 0; dvb < 2; ++dvb) o[dvb] = MFMA(vf[1][s2][dvb], pb, o[dvb]);
  }
  const f32x16 sv = t0 + t1;
  typedef float f32x8 __attribute__((ext_vector_type(8)));
  typedef float f32x4v __attribute__((ext_vector_type(4)));
  typedef float f32x2v __attribute__((ext_vector_type(2)));
  const f32x8 s8 = __builtin_shufflevector(sv, sv, 0, 1, 2, 3, 4, 5, 6, 7) + __builtin_shufflevector(sv, sv, 8, 9, 10, 11, 12, 13, 14, 15);
  const f32x4v s4 = __builtin_shufflevector(s8, s8, 0, 1, 2, 3) + __builtin_shufflevector(s8, s8, 4, 5, 6, 7);
  const f32x2v s2 = __builtin_shufflevector(s4, s4, 0, 1) + __builtin_shufflevector(s4, s4, 2, 3);
  lsum += s2[0] + s2[1];
}

DI void mla_tile(const Params& p, int tile, char* lds) {
  const int tid = otid(), lane = tid & 63, w = tid >> 6, r = lane & 31, hh = lane >> 5;
  const int qt = 31 - (tile >> 5), bh = tile & 31, b = bh >> 3, hd = bh & 7;
  const int q0 = qt * 256, qw0 = q0 + 32 * w, q = qw0 + r;
  bf16x8 qf[6];
  {
    const u16* Qp = (const u16*)(wsp(p) + OFF_QMLA) + ((size_t)bh * S + q) * 96 + 8 * hh;
#pragma unroll
    for (int s = 0; s < 6; ++s) qf[s] = *(const bf16x8*)(Qp + 16 * s);
    const int pos = ((const int*)inp(p, 1))[b * S + q];
#pragma unroll
    for (int j = 0; j < 8; ++j) {
      float c, sn;
      sincos_pos(pos, INVF[8 * hh + j], c, sn);
      const float x1 = bf2f((u16)qf[4][j]), x2 = bf2f((u16)qf[5][j]);
      qf[4][j] = (short)f2bf(x1 * c - x2 * sn);
      qf[5][j] = (short)f2bf(x2 * c + x1 * sn);
    }
  }
  const u16* Kg = (const u16*)(wsp(p) + OFF_KMLA) + (size_t)bh * S * 96;
  const u16* Vg = (const u16*)(wsp(p) + OFF_VTMLA) + (size_t)bh * 64 * S;
  int koff[2], voff;
#pragma unroll
  for (int i = 0; i < 2; ++i) {
    const int id = tid + 512 * i, row = id / 12, c = id % 12;
    koff[i] = row * 256 + ((c ^ (row & 15)) << 4);
  }
  {
    const int row = tid >> 3, c = tid & 7;
    voff = 16384 + row * 128 + ((c ^ ((row >> 1) & 7)) << 4);
  }
  u32x4 rk[2], rv;
  auto gload = [&](int kt) {
    rk[0] = *(const u32x4*)(Kg + (size_t)kt * 64 * 96 + (size_t)tid * 8);
    if (tid < 256) rk[1] = *(const u32x4*)(Kg + (size_t)kt * 64 * 96 + (size_t)(tid + 512) * 8);
    rv = *(const u32x4*)(Vg + (size_t)(tid >> 3) * S + kt * 64 + (tid & 7) * 8);
  };
  f32x16 o[2];
  o[0] = zero16(); o[1] = zero16();
  float m = -1e30f, lsum = 0.f;
  const int nkt = 4 * qt + 4;
  gload(0);
  for (int kt = 0; kt < nkt; ++kt) {
    char* st = lds + (kt & 1) * 24576;
    *(u32x4*)(st + koff[0]) = rk[0];
    if (tid < 256) *(u32x4*)(st + koff[1]) = rk[1];
    *(u32x4*)(st + voff) = rv;
    __syncthreads();
    if (kt + 1 < nkt) gload(kt + 1);
    const int k0 = kt * 64;
    if (k0 <= qw0 + 31) {
      f32x16 sc[2];
      {
        bf16x8 kf[2][6];
#pragma unroll
        for (int kb = 0; kb < 2; ++kb)
#pragma unroll
          for (int s = 0; s < 6; ++s) kf[kb][s] = frag256(st, 32 * kb + r, 2 * s + hh);
        asm volatile("" ::: "memory");
#pragma unroll
        for (int kb = 0; kb < 2; ++kb) {
          sc[kb] = zero16();
#pragma unroll
          for (int s = 0; s < 6; ++s) sc[kb] = MFMA(kf[kb][s], qf[s], sc[kb]);
        }
      }
      bf16x8 vf[2][2][2];
#pragma unroll
      for (int kb = 0; kb < 2; ++kb)
#pragma unroll
        for (int s2 = 0; s2 < 2; ++s2)
#pragma unroll
          for (int dvb = 0; dvb < 2; ++dvb) vf[kb][s2][dvb] = frag128(st + 16384, 32 * dvb + r, 4 * kb + 2 * s2 + hh);
      asm volatile("" ::: "memory");
      if (k0 + 63 > qw0) softmax_step<true>(sc, C_MLA, m, lsum, o, k0, -1, q, true, hh, vf);
      else softmax_step<false>(sc, C_MLA, m, lsum, o, k0, -1, q, true, hh, vf);
    }
  }
  __syncthreads();
  lsum += __shfl_xor(lsum, 32, 64);
  const float inv = 1.f / lsum;
  u16* yo = (u16*)(wsp(p) + OFF_YMLA) + (size_t)(b * S + q) * 512 + hd * 64;
#pragma unroll
  for (int dvb = 0; dvb < 2; ++dvb)
#pragma unroll
    for (int g4 = 0; g4 < 4; ++g4)
      store_quad(yo + 32 * dvb + 8 * g4 + 4 * hh, o[dvb][4 * g4] * inv, o[dvb][4 * g4 + 1] * inv, o[dvb][4 * g4 + 2] * inv, o[dvb][4 * g4 + 3] * inv);
}

struct KVRegs { u32x4 k, v; };
DI void kv_gload(KVRegs& rg, const u16* Kg, const u16* Vg, size_t vld, int kt, int tid, bool with_v) {
  rg.k = *(const u32x4*)(Kg + (size_t)kt * 4096 + (size_t)tid * 8);
  if (with_v) rg.v = *(const u32x4*)(Vg + (size_t)(tid >> 3) * vld + kt * 64 + (tid & 7) * 8);
}
DI void kv_store(const KVRegs& rg, char* st, int tid, bool with_v) {
  const int row = tid >> 3, c = tid & 7;
  const int off = row * 128 + ((c ^ ((row >> 1) & 7)) << 4);
  *(u32x4*)(st + off) = rg.k;
  if (with_v) *(u32x4*)(st + 8192 + off) = rg.v;
}

DI void cmp_tile(const Params& p, int tile, char* lds) {
  const int tid = otid(), lane = tid & 63, w = tid >> 6, r = lane & 31, hh = lane >> 5;
  const int slab = tile & 7, qt = 127 - (tile >> 3), b = slab >> 1, g = slab & 1;
  const int q0 = qt * 64, tl = 8 * w + (r >> 2), tok = q0 + tl, head = g * 4 + (r & 3);
  bf16x8 qf[4];
  {
    const u16* Qp = (const u16*)(wsp(p) + OFF_QN) + ((size_t)(b * 8 + head) * S + tok) * 64 + 8 * hh;
#pragma unroll
    for (int s = 0; s < 4; ++s) qf[s] = *(const bf16x8*)(Qp + 16 * s);
  }
  float* imp = (float*)(lds + 32768);
#pragma unroll
  for (int i = 0; i < 16; ++i) imp[tid + 512 * i] = 0.f;
  const u16* Kg = (const u16*)(wsp(p) + OFF_KC) + (size_t)slab * 512 * 64;
  const u16* Vg = (const u16*)(wsp(p) + OFF_VCT) + (size_t)slab * 64 * 512;
  const int nkt = ((q0 + 32) >> 10) + 1;
  const int lim = tok - 31;
  KVRegs rg;
  float m = -1e30f, lsum = 0.f;
  kv_gload(rg, Kg, Vg, 512, 0, tid, false);
  for (int kt = 0; kt < nkt; ++kt) {
    char* st = lds + (kt & 1) * 16384;
    kv_store(rg, st, tid, false);
    __syncthreads();
    if (kt + 1 < nkt) kv_gload(rg, Kg, Vg, 512, kt + 1, tid, false);
    f32x16 sc[2];
#pragma unroll
    for (int kb = 0; kb < 2; ++kb) {
      sc[kb] = zero16();
#pragma unroll
      for (int s = 0; s < 4; ++s) sc[kb] = MFMA(frag128(st, 32 * kb + r, 2 * s + hh), qf[s], sc[kb]);
    }
    float mx = -1e30f;
#pragma unroll
    for (int kb = 0; kb < 2; ++kb)
#pragma unroll
      for (int i = 0; i < 16; ++i) {
        const int n = kt * 64 + 32 * kb + crow(i, hh);
        mx = fmaxf(mx, (16 * n <= lim) ? sc[kb][i] : -1e30f);
      }
    mx = fmaxf(mx, __shfl_xor(mx, 32, 64));
    const float mn = fmaxf(m, mx);
    const float alpha = __builtin_amdgcn_exp2f((m - mn) * C_NSA);
    m = mn;
    const float mc = mn * C_NSA;
    float rs = 0.f;
#pragma unroll
    for (int kb = 0; kb < 2; ++kb)
#pragma unroll
      for (int i = 0; i < 16; ++i) {
        const int n = kt * 64 + 32 * kb + crow(i, hh);
        const float pv = __builtin_amdgcn_exp2f(sc[kb][i] * C_NSA - mc);
        rs += (16 * n <= lim) ? pv : 0.f;
      }
    lsum = lsum * alpha + rs;
  }
  __syncthreads();
  lsum += __shfl_xor(lsum, 32, 64);
  const float invl = lsum > 0.f ? 1.f / lsum : 0.f;
  const float mc = m * C_NSA;
  f32x16 o[2];
  o[0] = zero16(); o[1] = zero16();
  float carry = 0.f;
  kv_gload(rg, Kg, Vg, 512, 0, tid, true);
  for (int kt = 0; kt < nkt; ++kt) {
    char* st = lds + (kt & 1) * 16384;
    kv_store(rg, st, tid, true);
    __syncthreads();
    if (kt + 1 < nkt) kv_gload(rg, Kg, Vg, 512, kt + 1, tid, true);
    f32x16 sc[2];
#pragma unroll
    for (int kb = 0; kb < 2; ++kb) {
      sc[kb] = zero16();
#pragma unroll
      for (int s = 0; s < 4; ++s) sc[kb] = MFMA(frag128(st, 32 * kb + r, 2 * s + hh), qf[s], sc[kb]);
    }
#pragma unroll
    for (int kb = 0; kb < 2; ++kb) {
#pragma unroll
      for (int i = 0; i < 16; ++i) {
        const int n = kt * 64 + 32 * kb + crow(i, hh);
        const float pv = __builtin_amdgcn_exp2f(sc[kb][i] * C_NSA - mc) * invl;
        sc[kb][i] = (16 * n <= lim) ? pv : 0.f;
      }
      float qs[4], ls[4], rc[4];
#pragma unroll
      for (int g4 = 0; g4 < 4; ++g4) {
        qs[g4] = (sc[kb][4 * g4] + sc[kb][4 * g4 + 1]) + (sc[kb][4 * g4 + 2] + sc[kb][4 * g4 + 3]);
        ls[g4] = sc[kb][4 * g4 + 3];
        qs[g4] += __shfl_xor(qs[g4], 1, 64);
        qs[g4] += __shfl_xor(qs[g4], 2, 64);
        ls[g4] += __shfl_xor(ls[g4], 1, 64);
        ls[g4] += __shfl_xor(ls[g4], 2, 64);
      }
#pragma unroll
      for (int g4 = 0; g4 < 4; ++g4) rc[g4] = __shfl_xor(ls[g4], 32, 64);
#pragma unroll
      for (int g4 = 0; g4 < 4; ++g4) {
        const float prev = (g4 > 0) ? rc[g4 > 0 ? g4 - 1 : 0] : carry;
        const float val = qs[g4] + (hh ? rc[g4] : prev);
        const int Q = 16 * kt + 8 * kb + 2 * g4 + hh;
        if ((r & 3) == 0) imp[tl * 128 + Q] = val;
      }
      carry = rc[3];
    }
#pragma unroll
    for (int kb = 0; kb < 2; ++kb)
#pragma unroll
      for (int s2 = 0; s2 < 2; ++s2) {
        const bf16x8 pb = pack8(sc[kb], s2);
#pragma unroll
        for (int dvb = 0; dvb < 2; ++dvb) o[dvb] = MFMA(frag128(st + 8192, 32 * dvb + r, 4 * kb + 2 * s2 + hh), pb, o[dvb]);
      }
  }
  __syncthreads();
  {
    const float g0 = sigmoidf_(((const float*)(wsp(p) + OFF_G))[(size_t)(b * S + tok) * 24 + head * 3]);
    u16* yo = (u16*)(wsp(p) + OFF_YNSA) + (size_t)(b * S + tok) * 512 + head * 64;
#pragma unroll
    for (int dvb = 0; dvb < 2; ++dvb)
#pragma unroll
      for (int g4 = 0; g4 < 4; ++g4)
        store_quad(yo + 32 * dvb + 8 * g4 + 4 * hh, o[dvb][4 * g4] * g0, o[dvb][4 * g4 + 1] * g0, o[dvb][4 * g4 + 2] * g0, o[dvb][4 * g4 + 3] * g0);
  }
  float* vals = (float*)(lds + 65536) + w * 128;
  for (int tt = 0; tt < 8; ++tt) {
    const int tl2 = 8 * w + tt, tok2 = q0 + tl2, cur = tok2 >> 6;
    const int m1 = lane, m2 = lane + 64;
    const float v1 = (m1 == 0 || m1 == cur || m1 == cur - 1) ? 1e6f : (m1 <= cur ? imp[tl2 * 128 + m1] : -1.f);
    const float v2 = (m2 == cur || m2 == cur - 1) ? 1e6f : (m2 <= cur ? imp[tl2 * 128 + m2] : -1.f);
    vals[m1] = v1;
    vals[m2] = v2;
    asm volatile("s_waitcnt lgkmcnt(0)" ::: "memory");
    int c1 = 0, c2 = 128;
    if (cur >= 64) {
      c2 = 0;
      for (int j = 0; j <= cur; j += 4) {
        const f32x4 vj = *(const f32x4*)(vals + j);
        c1 += (vj.x > v1 || (vj.x == v1 && j < m1)) ? 1 : 0;
        c1 += (vj.y > v1 || (vj.y == v1 && j + 1 < m1)) ? 1 : 0;
        c1 += (vj.z > v1 || (vj.z == v1 && j + 2 < m1)) ? 1 : 0;
        c1 += (vj.w > v1 || (vj.w == v1 && j + 3 < m1)) ? 1 : 0;
        c2 += (vj.x > v2 || (vj.x == v2 && j < m2)) ? 1 : 0;
        c2 += (vj.y > v2 || (vj.y == v2 && j + 1 < m2)) ? 1 : 0;
        c2 += (vj.z > v2 || (vj.z == v2 && j + 2 < m2)) ? 1 : 0;
        c2 += (vj.w > v2 || (vj.w == v2 && j + 3 < m2)) ? 1 : 0;
      }
    } else {
      for (int j = 0; j <= cur; j += 4) {
        const f32x4 vj = *(const f32x4*)(vals + j);
        c1 += (vj.x > v1 || (vj.x == v1 && j < m1)) ? 1 : 0;
        c1 += (vj.y > v1 || (vj.y == v1 && j + 1 < m1)) ? 1 : 0;
        c1 += (vj.z > v1 || (vj.z == v1 && j + 2 < m1)) ? 1 : 0;
        c1 += (vj.w > v1 || (vj.w == v1 && j + 3 < m1)) ? 1 : 0;
      }
    }
    const unsigned long long b1 = __ballot(c1 < 16 && v1 >= 0.f);
    const unsigned long long b2 = __ballot(c2 < 16 && v2 >= 0.f);
    if (lane == 0)
      *(u32x4*)(wsp(p) + OFF_SEL + ((size_t)slab * S + tok2) * 16) = mk_u4((unsigned)b1, (unsigned)(b1 >> 32), (unsigned)b2, (unsigned)(b2 >> 32));
    asm volatile("s_waitcnt lgkmcnt(0)" ::: "memory");
  }
  __syncthreads();
}

DI void nsa_tile(const Params& p, int tile, char* lds) {
  const int tid = otid(), lane = tid & 63, w = tid >> 6, r = lane & 31, hh = lane >> 5;
  const int slab = tile & 7, qt = 127 - (tile >> 3), b = slab >> 1, g = slab & 1;
  const int q0 = qt * 64, tl = 8 * w + (r >> 2), tok = q0 + tl, head = g * 4 + (r & 3);
  bf16x8 qf[4];
  {
    const u16* Qp = (const u16*)(wsp(p) + OFF_QN) + ((size_t)(b * 8 + head) * S + tok) * 64 + 8 * hh;
#pragma unroll
    for (int s = 0; s < 4; ++s) qf[s] = *(const bf16x8*)(Qp + 16 * s);
  }
  const u32x4 sm = *(const u32x4*)(wsp(p) + OFF_SEL + ((size_t)slab * S + tok) * 16);
  const float* gp = (const float*)(wsp(p) + OFF_G) + (size_t)(b * S + tok) * 24 + head * 3;
  f32x16 outa[2];
  outa[0] = zero16(); outa[1] = zero16();
  KVRegs rg;
  for (int mode = 0; mode < 2; ++mode) {
    const u16* Kg = (const u16*)(wsp(p) + (mode ? OFF_KWIN : OFF_KSLC)) + (size_t)slab * S * 64;
    const u16* Vg = (const u16*)(wsp(p) + (mode ? OFF_VWT : OFF_VST)) + (size_t)slab * 64 * S;
    const int kt_lo = mode ? ((q0 > 511 ? q0 - 511 : 0) >> 6) : 0;
    const int kt_hi = q0 >> 6;
    const int lo = mode ? tok - 512 : -1;
    f32x16 o[2];
    o[0] = zero16(); o[1] = zero16();
    float m = -1e30f, lsum = 0.f;
    kv_gload(rg, Kg, Vg, S, kt_lo, tid, true);
    for (int kt = kt_lo; kt <= kt_hi; ++kt) {
      char* st = lds + ((kt - kt_lo) & 1) * 16384;
      kv_store(rg, st, tid, true);
      __syncthreads();
      if (kt < kt_hi) kv_gload(rg, Kg, Vg, S, kt + 1, tid, true);
      const unsigned word = kt < 32 ? sm.x : kt < 64 ? sm.y : kt < 96 ? sm.z : sm.w;
      const bool bit = mode ? true : (((word >> (kt & 31)) & 1u) != 0);
      if (__ballot(bit) != 0ull) {
        const int k0 = kt * 64;
        f32x16 sc[2];
        {
          bf16x8 kf[2][4];
#pragma unroll
          for (int kb = 0; kb < 2; ++kb)
#pragma unroll
            for (int s = 0; s < 4; ++s) kf[kb][s] = frag128(st, 32 * kb + r, 2 * s + hh);
          asm volatile("" ::: "memory");
#pragma unroll
          for (int kb = 0; kb < 2; ++kb) {
            sc[kb] = zero16();
#pragma unroll
            for (int s = 0; s < 4; ++s) sc[kb] = MFMA(kf[kb][s], qf[s], sc[kb]);
          }
        }
        bf16x8 vf[2][2][2];
#pragma unroll
        for (int kb = 0; kb < 2; ++kb)
#pragma unroll
          for (int s2 = 0; s2 < 2; ++s2)
#pragma unroll
            for (int dvb = 0; dvb < 2; ++dvb) vf[kb][s2][dvb] = frag128(st + 8192, 32 * dvb + r, 4 * kb + 2 * s2 + hh);
        asm volatile("" ::: "memory");
        const bool need_mask = (k0 + 63 > q0 + 8 * w) || (mode && k0 <= q0 + 8 * w + 7 - 512);
        if (need_mask) softmax_step<true>(sc, C_NSA, m, lsum, o, k0, lo, tok, bit, hh, vf);
        else softmax_step<false>(sc, C_NSA, m, lsum, o, k0, lo, tok, bit, hh, vf);
      }
    }
    __syncthreads();
    lsum += __shfl_xor(lsum, 32, 64);
    const float gate = sigmoidf_(gp[1 + mode]);
    const float sc_ = lsum > 0.f ? gate / lsum : 0.f;
#pragma unroll
    for (int i = 0; i < 16; ++i) { outa[0][i] += o[0][i] * sc_; outa[1][i] += o[1][i] * sc_; }
  }
  u16* yo = (u16*)(wsp(p) + OFF_YNSA) + (size_t)(b * S + tok) * 512 + head * 64;
#pragma unroll
  for (int dvb = 0; dvb < 2; ++dvb)
#pragma unroll
    for (int g4 = 0; g4 < 4; ++g4) {
      u16* d = yo + 32 * dvb + 8 * g4 + 4 * hh;
      const u32x2 pc = *(const u32x2*)d;
      store_quad(d, outa[dvb][4 * g4] + bflo(pc.x), outa[dvb][4 * g4 + 1] + bfhi(pc.x), outa[dvb][4 * g4 + 2] + bflo(pc.y), outa[dvb][4 * g4 + 3] + bfhi(pc.y));
    }
}

DI void phaseF(const Params& p, int l, char* lds) {
  const u16* wl = (const u16*)wsp(p) + (size_t)l * W_LAYER;
  const u16* h = (const u16*)(wsp(p) + OFF_H);
  u16* merged = (u16*)(wsp(p) + OFF_MERGED);
  int pre = -1;
  for (int j = 0; j * (int)gridDim.x < 128 * 8; ++j) {
    int mt, nt;
    if (!tile_mn(j, 8, 128 * 8, mt, nt)) continue;
    int mt2 = 0, nt2 = 0;
    const bool has_next = ((j + 1) * (int)gridDim.x < 128 * 8) && tile_mn(j + 1, 8, 128 * 8, mt2, nt2);
    const int m0 = mt * 256, n0 = nt * 128;
    unsigned fpk[4][8];
#pragma unroll
    for (int mi = 0; mi < 4; ++mi)
#pragma unroll
      for (int e = 0; e < 8; ++e) fpk[mi][e] = 0u;
#pragma unroll 1
    for (int i = 0; i < 3; ++i) {
      unsigned gpk[4][8];
      {
        f32x16 ga[4][1];
        zero_acc<1>(ga);
        const u16* yb = (const u16*)(wsp(p) + (i == 0 ? OFF_YCONV : i == 1 ? OFF_YMLA : OFF_YNSA));
        const u16* wbb = wl + (i == 0 ? W_BC : i == 1 ? W_BM : W_BN);
        pre = gemm_acc_chain<1>(h + (size_t)m0 * 1024, 1024, wl + W_IN + (size_t)(i * 1024 + n0) * 1024, 1024, 1024, ga, lds, pre,
                                yb + (size_t)m0 * 512, 512, wbb + (size_t)n0 * 512, 512);
#pragma unroll
        for (int mi = 0; mi < 4; ++mi)
#pragma unroll
          for (int e = 0; e < 8; ++e) gpk[mi][e] = pack2(sigmoidf_(ga[mi][0][2 * e]), sigmoidf_(ga[mi][0][2 * e + 1]));
      }
      f32x16 ba[4][1];
      zero_acc<1>(ba);
      const u16* y = (const u16*)(wsp(p) + (i == 0 ? OFF_YCONV : i == 1 ? OFF_YMLA : OFF_YNSA));
      const u16* wb = wl + (i == 0 ? W_BC : i == 1 ? W_BM : W_BN);
      {
        const bool last = (i == 2);
        const u16* nA = last ? (has_next ? h + (size_t)(mt2 * 256) * 1024 : nullptr) : h + (size_t)m0 * 1024;
        const u16* nB = last ? wl + W_IN + (size_t)(nt2 * 128) * 1024 : wl + W_IN + (size_t)((i + 1) * 1024 + n0) * 1024;
        const int nb = gemm_acc_chain<1>(y + (size_t)m0 * 512, 512, wb + (size_t)n0 * 512, 512, 512, ba, lds, pre, nA, 1024, nB, 1024);
        pre = nA ? nb : -1;
      }
#pragma unroll
      for (int mi = 0; mi < 4; ++mi)
#pragma unroll
        for (int e = 0; e < 8; ++e)
          fpk[mi][e] = pack2(bflo(fpk[mi][e]) + bflo(gpk[mi][e]) * ba[mi][0][2 * e], bfhi(fpk[mi][e]) + bfhi(gpk[mi][e]) * ba[mi][0][2 * e + 1]);
    }
    {
      const int tid = otid(), lane = tid & 63, w = tid >> 6, r = lane & 31, hh = lane >> 5, wm = w >> 2, wn = w & 3;
#pragma unroll
      for (int mi = 0; mi < 4; ++mi)
#pragma unroll
        for (int g4 = 0; g4 < 4; ++g4) {
          const int m = m0 + 128 * wm + 32 * mi + 8 * g4 + 4 * hh;
          const int n = n0 + 32 * wn + r;
          u16* q = merged + (size_t)m * 1024 + n;
          q[0] = (u16)(fpk[mi][2 * g4] & 0xffffu);
          q[1024] = (u16)(fpk[mi][2 * g4] >> 16);
          q[2048] = (u16)(fpk[mi][2 * g4 + 1] & 0xffffu);
          q[3072] = (u16)(fpk[mi][2 * g4 + 1] >> 16);
        }
    }
  }
}

DI void gemm_phase(const u16* A, int lda, const u16* Bt, int K, int Ntiles, u16* C, int ldc, char* lds) {
  const int ntot = 128 * Ntiles;
  bool pre = false;
  for (int j = 0; j * (int)gridDim.x < ntot; ++j) {
    int mt, nt;
    if (!tile_mn(j, Ntiles, ntot, mt, nt)) continue;
    const int m0 = mt * 256, n0 = nt * 256;
    int mt2 = 0, nt2 = 0;
    const bool has_next = ((j + 1) * (int)gridDim.x < ntot) && tile_mn(j + 1, Ntiles, ntot, mt2, nt2);
    f32x4m acc[2][2][4][2];
    zero_acc8(acc);
    gemm8_acc(A + (size_t)m0 * lda, lda, Bt + (size_t)n0 * K, K, K, acc, lds, pre);
    if (has_next) gemm8_prologue(A + (size_t)(mt2 * 256) * lda, lda, Bt + (size_t)(nt2 * 256) * K, K, lds);
    pre = has_next;
    epi8_apply(acc, m0, n0, [&](int m, int n, float v0, float v1, float v2, float v3) { store_rows(C, ldc, m, n, v0, v1, v2, v3); });
  }
}

DI void phaseJ(const Params& p, int l) {
  u16* U = (u16*)(wsp(p) + OFF_U);
  const float* cw = (const float*)inp(p, 21) + (size_t)l * 3 * DFF;
  const float* cb = (const float*)inp(p, 22) + (size_t)l * DFF;
  const int nthr = gridDim.x * 512;
  constexpr int RUN = 16;
  for (int idx = blockIdx.x * 512 + otid(); idx < (T / RUN) * 352; idx += nthr) {
    const int run = idx / 352, c0 = (idx % 352) * 8;
    const int t0 = run * RUN, s0 = t0 & (S - 1);
    float w[3][8], bias[8], a0[8], a1[8];
#pragma unroll
    for (int k = 0; k < 3; ++k) {
      const f32x4 x0 = *(const f32x4*)(cw + k * DFF + c0), x1 = *(const f32x4*)(cw + k * DFF + c0 + 4);
      w[k][0] = x0.x; w[k][1] = x0.y; w[k][2] = x0.z; w[k][3] = x0.w; w[k][4] = x1.x; w[k][5] = x1.y; w[k][6] = x1.z; w[k][7] = x1.w;
    }
    {
      const f32x4 x0 = *(const f32x4*)(cb + c0), x1 = *(const f32x4*)(cb + c0 + 4);
      bias[0] = x0.x; bias[1] = x0.y; bias[2] = x0.z; bias[3] = x0.w; bias[4] = x1.x; bias[5] = x1.y; bias[6] = x1.z; bias[7] = x1.w;
    }
    {
      u32x4 u0 = mk_u4(0u, 0u, 0u, 0u), u1 = mk_u4(0u, 0u, 0u, 0u);
      if (s0 > 0) {
        u0 = *(const u32x4*)(U + (size_t)(t0 - 2) * 5632 + c0);
        u1 = *(const u32x4*)(U + (size_t)(t0 - 1) * 5632 + c0);
      }
      a0[0] = bflo(u0.x); a0[1] = bfhi(u0.x); a0[2] = bflo(u0.y); a0[3] = bfhi(u0.y); a0[4] = bflo(u0.z); a0[5] = bfhi(u0.z); a0[6] = bflo(u0.w); a0[7] = bfhi(u0.w);
      a1[0] = bflo(u1.x); a1[1] = bfhi(u1.x); a1[2] = bflo(u1.y); a1[3] = bfhi(u1.y); a1[4] = bflo(u1.z); a1[5] = bfhi(u1.z); a1[6] = bflo(u1.w); a1[7] = bfhi(u1.w);
    }
    for (int tb = 0; tb < RUN; tb += 8) {
      u32x4 uas[8], ubs[8];
#pragma unroll
      for (int q = 0; q < 8; ++q) {
        const u16* rowp = U + (size_t)(t0 + tb + q) * 5632 + c0;
        uas[q] = __builtin_nontemporal_load((const u32x4*)rowp);
        ubs[q] = __builtin_nontemporal_load((const u32x4*)(rowp + DFF));
      }
#pragma unroll
      for (int q = 0; q < 8; ++q) {
        const u32x4 ua = uas[q], ub = ubs[q];
        const float a2[8] = {bflo(ua.x), bfhi(ua.x), bflo(ua.y), bfhi(ua.y), bflo(ua.z), bfhi(ua.z), bflo(ua.w), bfhi(ua.w)};
        const float bv[8] = {bflo(ub.x), bfhi(ub.x), bflo(ub.y), bfhi(ub.y), bflo(ub.z), bfhi(ub.z), bflo(ub.w), bfhi(ub.w)};
        float z[8];
#pragma unroll
        for (int j = 0; j < 8; ++j) {
          const float x = bias[j] + w[0][j] * a0[j] + w[1][j] * a1[j] + w[2][j] * a2[j];
          const float u = 0.7978845608028654f * (x + 0.044715f * x * x * x);
          const float th = 1.f - 2.f * __builtin_amdgcn_rcpf(__expf(2.f * u) + 1.f);
          z[j] = 0.5f * x * (1.f + th) * bv[j];
          a0[j] = a1[j];
          a1[j] = a2[j];
        }
        *(u32x4*)(U + (size_t)(t0 + tb + q) * 5632 + c0 + DFF) = mk_u4(pack2(z[0], z[1]), pack2(z[2], z[3]), pack2(z[4], z[5]), pack2(z[6], z[7]));
      }
    }
  }
}

#define XB_TMO      128
#define XB_XCNT(j)  (256  + 64 * (j))
#define XB_XSUB(j)  (1280 + 64 * (j))
#define XB_XGEN(j)  (2304 + 64 * (j))
#define XB_TOP      3328
#define XB_TOPGEN   3392
#define XCD_BAR_WORDS 3456
#define XB_SPIN_CAP (1u << 20)
#define LAS __attribute__((address_space(3)))
DI unsigned xb_ld(unsigned* p) { return __hip_atomic_load(p, __ATOMIC_RELAXED, __HIP_MEMORY_SCOPE_AGENT); }
DI unsigned xb_add(unsigned* p, unsigned v) { return __hip_atomic_fetch_add(p, v, __ATOMIC_RELAXED, __HIP_MEMORY_SCOPE_AGENT); }
DI unsigned xb_xcc_id() { return (unsigned)__builtin_amdgcn_s_getreg((3 << 11) | 20) & 0xFu; }
#define XB_SPIN(cond, bar) do { unsigned _sp = 0; while (cond) { __builtin_amdgcn_s_sleep(1); \
    if ((++_sp & 255u) == 0u) { if (xb_ld(&(bar)[XB_TMO])) break; if (_sp > XB_SPIN_CAP) { atomicAdd(&(bar)[XB_TMO], 1u); break; } } } } while (0)
struct XcdBarrier { unsigned* bar; unsigned x; volatile LAS unsigned* st; };
DI XcdBarrier xcd_barrier_post(unsigned* bar, volatile LAS unsigned* st) {
  XcdBarrier b; b.bar = bar; b.x = xb_xcc_id(); b.st = st;
  if (threadIdx.x == 0) (void)xb_add(&bar[XB_XCNT(b.x)], 1u);
  return b;
}
DI void xcd_barrier_complete(unsigned* bar, unsigned x, unsigned& nloc, unsigned& nx) {
  const unsigned G = gridDim.x * gridDim.y * gridDim.z;
  unsigned sum, cnt, mine, sp = 0u;
  for (;;) {
    sum = 0u; cnt = 0u; mine = 0u;
#pragma unroll
    for (unsigned j = 0; j < 16; ++j) { const unsigned c = xb_ld(&bar[XB_XCNT(j)]); sum += c; cnt += (c > 0u) ? 1u : 0u; mine = (j == x) ? c : mine; }
    if (sum == G) break;
    __builtin_amdgcn_s_sleep(1);
    if ((++sp & 255u) == 0u) { if (xb_ld(&bar[XB_TMO])) break; if (sp > XB_SPIN_CAP) { atomicAdd(&bar[XB_TMO], 1u); break; } }
  }
  nloc = mine > 0u ? mine : 1u; nx = cnt > 0u ? cnt : 1u;
}
DI void xcd_barrier(const XcdBarrier& b) {
  asm volatile("s_waitcnt vmcnt(0)" ::: "memory");
  __syncthreads();
  if (threadIdx.x == 0) {
    unsigned* bar = b.bar;
    __builtin_amdgcn_s_waitcnt(0);
    unsigned nloc = b.st[0], nx = b.st[1];
    if (nloc == 0u) { xcd_barrier_complete(bar, b.x, nloc, nx); b.st[0] = nloc; b.st[1] = nx; }
    const unsigned old = xb_add(&bar[XB_XSUB(b.x)], 1u);
    const unsigned gen = old / nloc;
    if (old + 1u == (gen + 1u) * nloc) {
      __builtin_amdgcn_fence(__ATOMIC_RELEASE, "agent");
      asm volatile("s_waitcnt vmcnt(0)" ::: "memory");
      const unsigned og = xb_add(&bar[XB_TOP], 1u);
      const unsigned tg = og / nx;
      if (og + 1u == (tg + 1u) * nx) xb_add(&bar[XB_TOPGEN], 1u);
      else XB_SPIN(xb_ld(&bar[XB_TOPGEN]) == tg, bar);
      __builtin_amdgcn_fence(__ATOMIC_ACQUIRE, "agent");
      xb_add(&bar[XB_XGEN(b.x)], 1u);
      asm volatile("s_waitcnt vmcnt(0)" ::: "memory");
    } else {
      XB_SPIN(xb_ld(&bar[XB_XGEN(b.x)]) == gen, bar);
      __builtin_amdgcn_fence(__ATOMIC_ACQUIRE, "agent");
      asm volatile("s_waitcnt vmcnt(0)" ::: "memory");
    }
  }
  __syncthreads();
}

__global__ void __launch_bounds__(512, 2) fwd_megakernel(Params p) {
  __shared__ __attribute__((aligned(1024))) char lds[131072 + 1024];
  cg::grid_group grid = cg::this_grid();
  if (threadIdx.x < 4) ((unsigned*)(lds + 131072))[threadIdx.x] = 0u;
  __syncthreads();
  XcdBarrier xb = xcd_barrier_post((unsigned*)(p.ws + OFF_BAR), (volatile LAS unsigned*)(lds + 131072));
  const int lane = otid() & 63, gw = blockIdx.x * 8 + (otid() >> 6), nw = gridDim.x * 8;
  phase0(p, lds);
  grid.sync();
  for (int l = 0; l < 2; ++l) {
    const u16* wl = (const u16*)wsp(p) + (size_t)l * W_LAYER;
    phaseA(p, l, lds);
    xcd_barrier(xb);
    phaseB(p, l);
    xcd_barrier(xb);
    phaseC(p, l, lds);
    xcd_barrier(xb);
    for (int j = 0; j * (int)gridDim.x < 2048; ++j) {
      const int t2 = j * gridDim.x + blockIdx.x;
      if (t2 >= 2048) break;
      if ((blockIdx.x + j) & 1) {
        cmp_tile(p, t2 >> 1, lds);
        __threadfence_block();
        __syncthreads();
        nsa_tile(p, t2 >> 1, lds);
      } else {
        mla_tile(p, t2 >> 1, lds);
      }
    }
    xcd_barrier(xb);
    phaseF(p, l, lds);
    xcd_barrier(xb);
    gemm_phase((const u16*)(wsp(p) + OFF_MERGED), 1024, wl + W_OUT, 1024, 4, (u16*)(wsp(p) + OFF_O), 1024, lds);
    xcd_barrier(xb);
    {
      const float* xs = l == 0 ? (const float*)inp(p, 0) : p.out;
      rowpass_all(xs, p.out, (const u16*)(wsp(p) + OFF_O), (const float*)inp(p, 3) + l * 1024, (const float*)inp(p, 18) + l * 1024, (u16*)(wsp(p) + OFF_H));
    }
    xcd_barrier(xb);
    gemm_phase((const u16*)(wsp(p) + OFF_H), 1024, wl + W_UP, 1024, 22, (u16*)(wsp(p) + OFF_U), 5632, lds);
    xcd_barrier(xb);
    phaseJ(p, l);
    xcd_barrier(xb);
    gemm_phase((const u16*)(wsp(p) + OFF_U) + DFF, 5632, wl + W_DOWN, DFF, 4, (u16*)(wsp(p) + OFF_H), 1024, lds);
    xcd_barrier(xb);
    {
      const float* gnext = l == 0 ? (const float*)inp(p, 2) + 1024 : nullptr;
      rowpass_all(p.out, p.out, (const u16*)(wsp(p) + OFF_H), (const float*)inp(p, 19) + l * 1024, gnext, (u16*)(wsp(p) + OFF_H));
    }
    if (l == 0) xcd_barrier(xb);
  }
}

extern "C" void kernel_launch(void* const* d_in, const int* in_sizes, int n_in, void* d_out, int out_size, void* d_ws, size_t ws_size,
                              hipStream_t stream) {
  static int grid_blocks = 0;
  if (!grid_blocks) {
    int dev = 0, cus = 0, per_cu = 0;
    hipGetDevice(&dev);
    hipDeviceGetAttribute(&cus, hipDeviceAttributeMultiprocessorCount, dev);
    hipOccupancyMaxActiveBlocksPerMultiprocessor(&per_cu, fwd_megakernel, 512, 0);
    if (per_cu > 1) per_cu = 1;
    grid_blocks = cus * per_cu;
  }
  Params p{};
  for (int i = 0; i < 24; ++i) p.in[i] = d_in[i];
  p.out = (float*)d_out;
  p.ws = (char*)d_ws;
  hipMemsetAsync((char*)d_ws + OFF_BAR, 0, XCD_BAR_WORDS * sizeof(unsigned), stream);
  void* args[] = {&p};
  hipError_t e = hipLaunchCooperativeKernel((void*)fwd_megakernel, dim3(grid_blocks), dim3(512), args, 0, stream);
  if (e != hipSuccess) fprintf(stderr, "cooperative launch failed: %s (grid %d)\n", hipGetErrorString(e), grid_blocks);
}
```

```cpp
#include <hip/hip_runtime.h>
#include <hip/hip_cooperative_groups.h>
#include <cstdio>
namespace cg = cooperative_groups;

#define DI __device__ __forceinline__
typedef unsigned short u16;
typedef short bf16x8 __attribute__((ext_vector_type(8)));
typedef float f32x16 __attribute__((ext_vector_type(16)));
typedef __bf16 bf2_t __attribute__((ext_vector_type(2)));
typedef float f2_t __attribute__((ext_vector_type(2)));
typedef unsigned u32x4 __attribute__((ext_vector_type(4)));
typedef unsigned u32x2 __attribute__((ext_vector_type(2)));
typedef float f32x4 __attribute__((ext_vector_type(4)));

constexpr int NB = 4, S = 8192, T = NB * S;
constexpr int N1 = 3512;
constexpr int DFF = 2816;
constexpr size_t MiB = 1ull << 20;

constexpr size_t W_IN = 0;
constexpr size_t W_UQ = W_IN + 6656ull * 1024;
constexpr size_t W_UKV = W_UQ + 768ull * 384;
constexpr size_t W_CK = W_UKV + 1024ull * 256;
constexpr size_t W_CV = W_CK + 64ull * 2048;
constexpr size_t W_BC = W_CV + 64ull * 2048;
constexpr size_t W_BM = W_BC + 1024ull * 512;
constexpr size_t W_BN = W_BM + 1024ull * 512;
constexpr size_t W_OUT = W_BN + 1024ull * 512;
constexpr size_t W_UP = W_OUT + 1024ull * 1024;
constexpr size_t W_DOWN = W_UP + 5632ull * 1024;
constexpr size_t W_LAYER = W_DOWN + 1024ull * 2816;

constexpr size_t OFF_BIAS = 73 * MiB;
constexpr size_t OFF_BAR = 73 * MiB + 65536;
constexpr size_t OFF_H = 74 * MiB;
constexpr size_t OFF_P1A = 138 * MiB;
constexpr size_t OFF_P1B = 234 * MiB;
constexpr size_t OFF_YCONV = 276 * MiB;
constexpr size_t OFF_QN = 308 * MiB;
constexpr size_t OFF_KCMP = 340 * MiB;
constexpr size_t OFF_VCMP = 348 * MiB;
constexpr size_t OFF_KSLC = 356 * MiB;
constexpr size_t OFF_KWIN = 364 * MiB;
constexpr size_t OFF_VST = 372 * MiB;
constexpr size_t OFF_VWT = 380 * MiB;
constexpr size_t OFF_G = 388 * MiB;
constexpr size_t OFF_KC = 391 * MiB;
constexpr size_t OFF_VCT = 391 * MiB + 512 * 1024;
constexpr size_t OFF_SEL = 392 * MiB;
constexpr size_t OFF_KMLA = 394 * MiB;
constexpr size_t OFF_YMLA = 442 * MiB;
constexpr size_t OFF_YNSA = 474 * MiB;
constexpr size_t OFF_QMLA = 138 * MiB;
constexpr size_t OFF_VTMLA = 186 * MiB;
constexpr size_t OFF_MERGED = 138 * MiB;
constexpr size_t OFF_O = 202 * MiB;
constexpr size_t OFF_U = 138 * MiB;

struct Params {
  const void* in[24];
  float* out;
  char* ws;
};

__device__ const double INVF[16] = {
    1.0, 0.44036660267178046, 0.19392274474868576, 0.08539710028576561, 0.03760603093086393, 0.016560440080994446,
    0.007292664737217109, 0.003211445994752591, 0.001414213562373095, 0.000622772421914596, 0.0002742481756762073,
    0.00012076973741146504, 5.318295896944988e-05, 2.341999896140934e-05, 1.031338537721246e-05, 4.5416704806078695e-06};

DI u32x4 mk_u4(unsigned a, unsigned b, unsigned c, unsigned d) { u32x4 v = {a, b, c, d}; return v; }
DI f32x4 mk_f4(float a, float b, float c, float d) { f32x4 v = {a, b, c, d}; return v; }
DI char* wsp(const Params& p) { size_t z = 0; asm volatile("" : "+s"(z)); return p.ws + z; }
DI const void* inp(const Params& p, int i) { size_t z = 0; asm volatile("" : "+s"(z)); return (const char*)p.in[i] + z; }
DI int otid() { int t = __builtin_amdgcn_workitem_id_x(); asm volatile("" : "+v"(t)); return t; }
DI unsigned pack2(float a, float b) {
  f2_t v = {a, b};
  bf2_t r = __builtin_convertvector(v, bf2_t);
  return __builtin_bit_cast(unsigned, r);
}
DI u16 f2bf(float a) { return (u16)(pack2(a, 0.f) & 0xffffu); }
DI float bf2f(u16 v) { return __uint_as_float(((unsigned)v) << 16); }
DI float bflo(unsigned v) { return __uint_as_float(v << 16); }
DI float bfhi(unsigned v) { return __uint_as_float(v & 0xffff0000u); }
DI float wave_sum(float v) {
#pragma unroll
  for (int o = 32; o > 0; o >>= 1) v += __shfl_xor(v, o, 64);
  return v;
}
DI int crow(int i, int hh) { return (i & 3) + 8 * (i >> 2) + 4 * hh; }
DI int permq(int s) {
  int qd = (s >> 2) & 3;
  int nq = ((qd & 1) << 1) | (qd >> 1);
  return (s & ~15) | (nq << 2);
}
DI void sincos_pos(int pos, double invf, float& c, float& s) {
  double rev = (double)pos * invf * 0.15915494309189535;
  rev -= floor(rev);
  float rf = (float)rev;
  s = __builtin_amdgcn_sinf(rf);
  c = __builtin_amdgcn_cosf(rf);
}
DI float sigmoidf_(float x) { return __builtin_amdgcn_rcpf(1.f + __expf(-x)); }
DI f32x16 zero16() {
  f32x16 z;
#pragma unroll
  for (int i = 0; i < 16; ++i) z[i] = 0.f;
  return z;
}
#define MFMA(a, b, c) __builtin_amdgcn_mfma_f32_32x32x16_bf16((a), (b), (c), 0, 0, 0)

#define WAIT_V0() asm volatile("s_waitcnt vmcnt(0)" ::: "memory")
template <int WN>
DI int gemm_acc_chain(const u16* __restrict__ A, int lda, const u16* __restrict__ Bt, int ldb, int K, f32x16 (&acc)[4][WN], char* lds, int pre,
                      const u16* nA, int nlda, const u16* nBt, int nldb) {
  constexpr int STAGE = 65536;
  constexpr int NBI = 2 * WN;
  const int tid = otid(), lane = tid & 63, w = tid >> 6, r = lane & 31, hh = lane >> 5, wm = w >> 2, wn = w & 3;
  const int srow = 8 * w + (lane >> 3);
  const int sc = (lane & 7) ^ ((srow >> 1) & 7);
  const int nk = K >> 6;
  auto stage = [&](const u16* A_, int lda_, const u16* Bt_, int ldb_, int buf, int k0) {
    char* sa = lds + buf * STAGE + w * 1024;
    const unsigned aoff = (unsigned)(srow * lda_ + sc * 8) * 2u;
    const unsigned boff = (unsigned)(srow * ldb_ + sc * 8) * 2u;
#pragma unroll
    for (int i = 0; i < 4; ++i)
      __builtin_amdgcn_global_load_lds((const unsigned*)((const char*)A_ + (aoff + (unsigned)((64 * i) * lda_ + k0) * 2u)), (unsigned*)(sa + i * 8192), 16, 0, 0);
#pragma unroll
    for (int i = 0; i < NBI; ++i)
      __builtin_amdgcn_global_load_lds((const unsigned*)((const char*)Bt_ + (boff + (unsigned)((64 * i) * ldb_ + k0) * 2u)), (unsigned*)(sa + 32768 + i * 8192), 16, 0, 0);
  };
  const int base = pre >= 0 ? pre : 0;
  if (pre < 0) {
    stage(A, lda, Bt, ldb, 0, 0);
    WAIT_V0();
    __syncthreads();
  }
  for (int kt = 0; kt < nk; ++kt) {
    const int buf = (base + kt) & 1;
    const char* st = lds + buf * STAGE;
    if (kt + 1 < nk) stage(A, lda, Bt, ldb, buf ^ 1, (kt + 1) << 6);
    else if (nA) stage(nA, nlda, nBt, nldb, buf ^ 1, 0);
#pragma unroll
    for (int s = 0; s < 4; ++s) {
      const int chunk = 2 * s + hh;
      bf16x8 a[4], b[WN];
#pragma unroll
      for (int mi = 0; mi < 4; ++mi) {
        const int row = 128 * wm + 32 * mi + r;
        a[mi] = *(const bf16x8*)(st + row * 128 + ((chunk ^ ((row >> 1) & 7)) << 4));
      }
#pragma unroll
      for (int ni = 0; ni < WN; ++ni) {
        const int row = 32 * WN * wn + 32 * ni + r;
        b[ni] = *(const bf16x8*)(st + 32768 + row * 128 + ((chunk ^ ((row >> 1) & 7)) << 4));
      }
#pragma unroll
      for (int mi = 0; mi < 4; ++mi)
#pragma unroll
        for (int ni = 0; ni < WN; ++ni) acc[mi][ni] = MFMA(a[mi], b[ni], acc[mi][ni]);
    }
    WAIT_V0();
    __syncthreads();
  }
  return (base + nk) & 1;
}
template <int WN>
DI void gemm_acc(const u16* __restrict__ A, int lda, const u16* __restrict__ Bt, int ldb, int K, f32x16 (&acc)[4][WN], char* lds) {
  (void)gemm_acc_chain<WN>(A, lda, Bt, ldb, K, acc, lds, -1, nullptr, 0, nullptr, 0);
}


typedef float f32x4m __attribute__((ext_vector_type(4)));
DI int g8_lds_byte(int r, int c) {
  const int st = (r >> 4) * 2 + (c >> 5), rr = r & 15, cc = c & 31, ob = rr * 64 + cc * 2;
  return st * 1024 + (ob ^ (((ob >> 9) & 1) << 5));
}
DI void gemm8_prologue(const u16* __restrict__ A, int lda, const u16* __restrict__ Bt, int ldb, char* lds) {
  constexpr int HTB = 16384;
  const int tid = otid();
  char* const sbase = lds + tid * 16;
#pragma unroll
  for (int h = 0; h < 2; ++h) {
#pragma unroll
    for (int i = 0; i < 2; ++i) {
      const int b = tid * 16 + i * 8192;
      const int st = b >> 10, sb = b & 1023, swz = sb ^ (((sb >> 9) & 1) << 5);
      const int R = (st >> 1) * 16 + (swz >> 6) + h * 128, C = (st & 1) * 32 + ((swz & 63) >> 1);
      __builtin_amdgcn_global_load_lds((const unsigned*)((const char*)Bt + (unsigned)(R * ldb + C) * 2u), (unsigned*)(sbase + (4 + h) * HTB + i * 8192), 16, 0, 0);
    }
#pragma unroll
    for (int i = 0; i < 2; ++i) {
      const int b = tid * 16 + i * 8192;
      const int st = b >> 10, sb = b & 1023, swz = sb ^ (((sb >> 9) & 1) << 5);
      const int R = (st >> 1) * 16 + (swz >> 6) + h * 128, C = (st & 1) * 32 + ((swz & 63) >> 1);
      __builtin_amdgcn_global_load_lds((const unsigned*)((const char*)A + (unsigned)(R * lda + C) * 2u), (unsigned*)(sbase + h * HTB + i * 8192), 16, 0, 0);
    }
  }
}
DI void gemm8_acc(const u16* __restrict__ A, int lda, const u16* __restrict__ Bt, int ldb, int K, f32x4m (&acc)[2][2][4][2], char* lds, bool pre = false) {
  constexpr int HTB = 16384;
  const int tid = otid(), wid = tid >> 6, lane = tid & 63, wr = wid >> 2, wc = wid & 3, fr = lane & 15, fq = lane >> 4;
  unsigned oa[2], ob_[2];
#pragma unroll
  for (int i = 0; i < 2; ++i) {
    const int b = tid * 16 + i * 8192;
    const int st = b >> 10, sb = b & 1023, swz = sb ^ (((sb >> 9) & 1) << 5);
    const int R = (st >> 1) * 16 + (swz >> 6), C = (st & 1) * 32 + ((swz & 63) >> 1);
    oa[i] = (unsigned)(R * lda + C) * 2u;
    ob_[i] = (unsigned)(R * ldb + C) * 2u;
  }
  char* const sbase = lds + tid * 16;
#define G8_SA(b, h) (lds + ((b) * 2 + (h)) * HTB)
#define G8_SB(b, h) (lds + (4 + (b) * 2 + (h)) * HTB)
#define G8_STAGE_A(b, h, kt) do { _Pragma("unroll") for (int _i = 0; _i < 2; ++_i) \
    __builtin_amdgcn_global_load_lds((const unsigned*)((const char*)A + (oa[_i] + (unsigned)((h) * 128 * lda + (kt) * 64) * 2u)), \
                                     (unsigned*)(sbase + ((b) * 2 + (h)) * HTB + _i * 8192), 16, 0, 0); } while (0)
#define G8_STAGE_B(b, h, kt) do { _Pragma("unroll") for (int _i = 0; _i < 2; ++_i) \
    __builtin_amdgcn_global_load_lds((const unsigned*)((const char*)Bt + (ob_[_i] + (unsigned)((h) * 128 * ldb + (kt) * 64) * 2u)), \
                                     (unsigned*)(sbase + (4 + (b) * 2 + (h)) * HTB + _i * 8192), 16, 0, 0); } while (0)
#define G8_LDA(dst, b, h) do { _Pragma("unroll") for (int m = 0; m < 4; ++m) _Pragma("unroll") for (int k = 0; k < 2; ++k) \
    dst[m][k] = *(const bf16x8*)(G8_SA(b, h) + g8_lds_byte(wr * 64 + m * 16 + fr, k * 32 + fq * 8)); } while (0)
#define G8_LDB(dst, b, h) do { _Pragma("unroll") for (int n = 0; n < 2; ++n) _Pragma("unroll") for (int k = 0; k < 2; ++k) \
    dst[n][k] = *(const bf16x8*)(G8_SB(b, h) + g8_lds_byte(wc * 32 + n * 16 + fr, k * 32 + fq * 8)); } while (0)
#define G8_MMA(ai, bj, At_, Bt_) do { __builtin_amdgcn_s_setprio(1); \
    _Pragma("unroll") for (int m = 0; m < 4; ++m) _Pragma("unroll") for (int n = 0; n < 2; ++n) _Pragma("unroll") for (int k = 0; k < 2; ++k) \
      acc[ai][bj][m][n] = __builtin_amdgcn_mfma_f32_16x16x32_bf16(At_[m][k], Bt_[n][k], acc[ai][bj][m][n], 0, 0, 0); \
    __builtin_amdgcn_s_setprio(0); } while (0)
#define G8_WV(n) asm volatile("s_waitcnt vmcnt(" #n ")" ::: "memory")
#define G8_WL(n) asm volatile("s_waitcnt lgkmcnt(" #n ")" ::: "memory")
#define G8_BAR __builtin_amdgcn_s_barrier()
#define G8_SCHED __builtin_amdgcn_sched_barrier(0)
  bf16x8 At[4][2], B0[2][2], B1[2][2];
  const int nt = K >> 6;
  if (!pre) { G8_STAGE_B(0, 0, 0); G8_STAGE_A(0, 0, 0); G8_STAGE_B(0, 1, 0); G8_STAGE_A(0, 1, 0); }
  if (wr == 1) G8_BAR;
  G8_WV(4); G8_BAR;
  G8_STAGE_B(1, 0, 1); G8_STAGE_A(1, 0, 1); G8_STAGE_B(1, 1, 1);
  G8_WV(6); G8_BAR;
  for (int t = 0; t < nt - 2; t += 2) {
    G8_LDB(B0, 0, 0); G8_SCHED; G8_LDA(At, 0, 0); G8_STAGE_A(1, 1, t + 1);
    G8_WL(8); G8_BAR; G8_WL(0); G8_MMA(0, 0, At, B0); G8_BAR; G8_SCHED;
    G8_LDB(B1, 0, 1); G8_STAGE_B(0, 0, t + 2);
    G8_BAR; G8_WL(0); G8_MMA(0, 1, At, B1); G8_BAR;
    G8_LDA(At, 0, 1); G8_STAGE_A(0, 0, t + 2);
    G8_BAR; G8_WL(0); G8_MMA(1, 0, At, B0); G8_BAR; G8_SCHED;
    G8_STAGE_B(0, 1, t + 2);
    G8_WV(6); G8_BAR; G8_MMA(1, 1, At, B1); G8_BAR;
    G8_LDB(B0, 1, 0); G8_SCHED; G8_LDA(At, 1, 0); G8_STAGE_A(0, 1, t + 2);
    G8_WL(8); G8_BAR; G8_WL(0); G8_MMA(0, 0, At, B0); G8_BAR; G8_SCHED;
    G8_LDB(B1, 1, 1); G8_STAGE_B(1, 0, t + 3);
    G8_BAR; G8_WL(0); G8_MMA(0, 1, At, B1); G8_BAR;
    G8_LDA(At, 1, 1); G8_STAGE_A(1, 0, t + 3);
    G8_BAR; G8_WL(0); G8_MMA(1, 0, At, B0); G8_BAR; G8_SCHED;
    G8_STAGE_B(1, 1, t + 3);
    G8_WV(6); G8_BAR; G8_MMA(1, 1, At, B1); G8_BAR;
  }
  {
    G8_LDB(B0, 0, 0); G8_LDA(At, 0, 0); G8_STAGE_A(1, 1, nt - 1);
    G8_BAR; G8_WL(0); G8_MMA(0, 0, At, B0); G8_BAR;
    G8_LDB(B1, 0, 1); G8_BAR; G8_WL(0); G8_MMA(0, 1, At, B1); G8_BAR;
    G8_LDA(At, 0, 1); G8_WV(4); G8_BAR; G8_WL(0); G8_MMA(1, 0, At, B0); G8_MMA(1, 1, At, B1); G8_BAR;
  }
  {
    G8_LDB(B0, 1, 0); G8_LDA(At, 1, 0); G8_WV(2); G8_BAR; G8_WL(0); G8_MMA(0, 0, At, B0); G8_BAR;
    G8_LDB(B1, 1, 1); G8_WV(0); G8_BAR; G8_WL(0); G8_MMA(0, 1, At, B1); G8_BAR;
    G8_LDA(At, 1, 1); G8_BAR; G8_WL(0); G8_MMA(1, 0, At, B0); G8_MMA(1, 1, At, B1); G8_BAR;
  }
  if (wr == 0) G8_BAR;
}
template <class F>
DI void epi8_apply(f32x4m (&acc)[2][2][4][2], int m0, int n0, F f) {
  const int tid = otid(), wid = tid >> 6, lane = tid & 63, wr = wid >> 2, wc = wid & 3, fr = lane & 15, fq = lane >> 4;
#pragma unroll
  for (int ai = 0; ai < 2; ++ai)
#pragma unroll
    for (int bj = 0; bj < 2; ++bj)
#pragma unroll
      for (int m = 0; m < 4; ++m)
#pragma unroll
        for (int n = 0; n < 2; ++n) {
          const f32x4m v = acc[ai][bj][m][n];
          f(m0 + ai * 128 + wr * 64 + m * 16 + fq * 4, n0 + bj * 128 + wc * 32 + n * 16 + fr, v[0], v[1], v[2], v[3]);
        }
}
DI void zero_acc8(f32x4m (&acc)[2][2][4][2]) {
#pragma unroll
  for (int ai = 0; ai < 2; ++ai)
#pragma unroll
    for (int bj = 0; bj < 2; ++bj)
#pragma unroll
      for (int m = 0; m < 4; ++m)
#pragma unroll
        for (int n = 0; n < 2; ++n) { f32x4m z = {0.f, 0.f, 0.f, 0.f}; acc[ai][bj][m][n] = z; }
}

template <int WN>
DI void zero_acc(f32x16 (&acc)[4][WN]) {
#pragma unroll
  for (int mi = 0; mi < 4; ++mi)
#pragma unroll
    for (int ni = 0; ni < WN; ++ni) acc[mi][ni] = zero16();
}

template <int WN, class F>
DI void epi_apply(f32x16 (&acc)[4][WN], int m0, int n0, F f) {
  const int tid = otid(), lane = tid & 63, w = tid >> 6, r = lane & 31, hh = lane >> 5, wm = w >> 2, wn = w & 3;
#pragma unroll
  for (int mi = 0; mi < 4; ++mi)
#pragma unroll
    for (int ni = 0; ni < WN; ++ni)
#pragma unroll
      for (int g4 = 0; g4 < 4; ++g4) {
        const int m = m0 + 128 * wm + 32 * mi + 8 * g4 + 4 * hh;
        const int n = n0 + 32 * WN * wn + 32 * ni + r;
        f(m, n, acc[mi][ni][4 * g4], acc[mi][ni][4 * g4 + 1], acc[mi][ni][4 * g4 + 2], acc[mi][ni][4 * g4 + 3]);
      }
}

DI void store_rows(u16* dst, size_t ld, int m, int n, float v0, float v1, float v2, float v3) {
  u16* q = dst + (size_t)m * ld + n;
  const unsigned a = pack2(v0, v1), b = pack2(v2, v3);
  q[0] = (u16)(a & 0xffffu);
  q[ld] = (u16)(a >> 16);
  q[2 * ld] = (u16)(b & 0xffffu);
  q[3 * ld] = (u16)(b >> 16);
}
DI void store_quad(u16* dst, float v0, float v1, float v2, float v3) {
  u32x2 u;
  u.x = pack2(v0, v1);
  u.y = pack2(v2, v3);
  *(u32x2*)dst = u;
}

template <int R>
DI void rowpass(const float* xs, float* xd, const u16* o, const float* gpost, const float* gnext, u16* hd, int row0, int stride, int lane) {
  float xv[R][16];
  float ov[R][16];
#pragma unroll
  for (int k = 0; k < R; ++k) {
    const float* xr = xs + (size_t)(row0 + k * stride) * 1024;
#pragma unroll
    for (int i = 0; i < 4; ++i) {
      f32x4 v = __builtin_nontemporal_load((const f32x4*)(xr + lane * 4 + 256 * i));
      xv[k][4 * i] = v.x; xv[k][4 * i + 1] = v.y; xv[k][4 * i + 2] = v.z; xv[k][4 * i + 3] = v.w;
    }
  }
  if (o) {
#pragma unroll
    for (int k = 0; k < R; ++k) {
      const u16* orow = o + (size_t)(row0 + k * stride) * 1024;
#pragma unroll
      for (int i = 0; i < 4; ++i) {
        u32x2 u = __builtin_nontemporal_load((const u32x2*)(orow + lane * 4 + 256 * i));
        ov[k][4 * i] = bflo(u.x); ov[k][4 * i + 1] = bfhi(u.x); ov[k][4 * i + 2] = bflo(u.y); ov[k][4 * i + 3] = bfhi(u.y);
      }
    }
    float gp[16];
#pragma unroll
    for (int i = 0; i < 4; ++i) {
      f32x4 g = *(const f32x4*)(gpost + lane * 4 + 256 * i);
      gp[4 * i] = g.x; gp[4 * i + 1] = g.y; gp[4 * i + 2] = g.z; gp[4 * i + 3] = g.w;
    }
    float ss[R];
#pragma unroll
    for (int k = 0; k < R; ++k) {
      ss[k] = 0.f;
#pragma unroll
      for (int i = 0; i < 16; ++i) ss[k] += ov[k][i] * ov[k][i];
    }
#pragma unroll
    for (int off = 32; off > 0; off >>= 1)
#pragma unroll
      for (int k = 0; k < R; ++k) ss[k] += __shfl_xor(ss[k], off, 64);
#pragma unroll
    for (int k = 0; k < R; ++k) {
      const float rs = rsqrtf(ss[k] * (1.f / 1024.f) + 1e-6f);
#pragma unroll
      for (int i = 0; i < 16; ++i) xv[k][i] += ov[k][i] * rs * gp[i];
      float* xw = xd + (size_t)(row0 + k * stride) * 1024;
#pragma unroll
      for (int i = 0; i < 4; ++i) __builtin_nontemporal_store(mk_f4(xv[k][4 * i], xv[k][4 * i + 1], xv[k][4 * i + 2], xv[k][4 * i + 3]), (f32x4*)(xw + lane * 4 + 256 * i));
    }
  }
  if (gnext) {
    float gn[16];
#pragma unroll
    for (int i = 0; i < 4; ++i) {
      f32x4 g = *(const f32x4*)(gnext + lane * 4 + 256 * i);
      gn[4 * i] = g.x; gn[4 * i + 1] = g.y; gn[4 * i + 2] = g.z; gn[4 * i + 3] = g.w;
    }
    float ss[R];
#pragma unroll
    for (int k = 0; k < R; ++k) {
      ss[k] = 0.f;
#pragma unroll
      for (int i = 0; i < 16; ++i) ss[k] += xv[k][i] * xv[k][i];
    }
#pragma unroll
    for (int off = 32; off > 0; off >>= 1)
#pragma unroll
      for (int k = 0; k < R; ++k) ss[k] += __shfl_xor(ss[k], off, 64);
#pragma unroll
    for (int k = 0; k < R; ++k) {
      const float rs = rsqrtf(ss[k] * (1.f / 1024.f) + 1e-6f);
      u16* hw = hd + (size_t)(row0 + k * stride) * 1024;
#pragma unroll
      for (int i = 0; i < 4; ++i) {
        u32x2 u;
        u.x = pack2(xv[k][4 * i] * rs * gn[4 * i], xv[k][4 * i + 1] * rs * gn[4 * i + 1]);
        u.y = pack2(xv[k][4 * i + 2] * rs * gn[4 * i + 2], xv[k][4 * i + 3] * rs * gn[4 * i + 3]);
        *(u32x2*)(hw + lane * 4 + 256 * i) = u;
      }
    }
  }
}
DI void rowpass_all(const float* xs, float* xd, const u16* o, const float* gpost, const float* gnext, u16* hd) {
  const int lane = otid() & 63, gw = blockIdx.x * 8 + (otid() >> 6), nw = gridDim.x * 8;
  int row = gw;
  for (; row + 3 * nw < T; row += 4 * nw) rowpass<4>(xs, xd, o, gpost, gnext, hd, row, nw, lane);
  for (; row < T; row += nw) rowpass<1>(xs, xd, o, gpost, gnext, hd, row, nw, lane);
}

DI void transpose_job(const float* __restrict__ src, u16* __restrict__ dst, int K, int N, int Npad, char* lds) {
  float* sm = (float*)lds;
  const int tid = otid();
  const int ktiles = K >> 6;
  const int ntiles = (Npad >> 6) * ktiles;
  for (int tile = blockIdx.x; tile < ntiles; tile += gridDim.x) {
    const int kt = tile % ktiles, nt = tile / ktiles;
    const int k0 = kt << 6, n0 = nt << 6;
    const int nl = tid & 63;
#pragma unroll
    for (int i = 0; i < 8; ++i) {
      const int kk = (tid >> 6) + 8 * i;
      const int n = n0 + nl;
      float v = (n < N) ? __builtin_nontemporal_load(src + (size_t)(k0 + kk) * N + n) : 0.f;
      sm[kk * 65 + nl] = v;
    }
    __syncthreads();
    const int nr = tid >> 3, seg = tid & 7;
    unsigned u[4];
#pragma unroll
    for (int j = 0; j < 4; ++j) u[j] = pack2(sm[(seg * 8 + 2 * j) * 65 + nr], sm[(seg * 8 + 2 * j + 1) * 65 + nr]);
    u16* d = dst + (size_t)(n0 + nr) * K + k0 + seg * 8;
    *(u32x4*)d = mk_u4(u[0], u[1], u[2], u[3]);
    __syncthreads();
  }
}

DI void phase0(const Params& p, char* lds) {
  u16* wbase = (u16*)wsp(p);
  for (int l = 0; l < 2; ++l) {
    u16* wl = wbase + (size_t)l * W_LAYER;
    transpose_job((const float*)inp(p, 4) + (size_t)l * 1024 * 6584, wl + W_IN, 1024, 6584, 6656, lds);
    transpose_job((const float*)inp(p, 7) + (size_t)l * 384 * 768, wl + W_UQ, 384, 768, 768, lds);
    transpose_job((const float*)inp(p, 9) + (size_t)l * 256 * 1024, wl + W_UKV, 256, 1024, 1024, lds);
    transpose_job((const float*)inp(p, 12) + (size_t)l * 2048 * 64, wl + W_CK, 2048, 64, 64, lds);
    transpose_job((const float*)inp(p, 13) + (size_t)l * 2048 * 64, wl + W_CV, 2048, 64, 64, lds);
    transpose_job((const float*)inp(p, 14) + (size_t)l * 512 * 1024, wl + W_BC, 512, 1024, 1024, lds);
    transpose_job((const float*)inp(p, 15) + (size_t)l * 512 * 1024, wl + W_BM, 512, 1024, 1024, lds);
    transpose_job((const float*)inp(p, 16) + (size_t)l * 512 * 1024, wl + W_BN, 512, 1024, 1024, lds);
    transpose_job((const float*)inp(p, 17) + (size_t)l * 1024 * 1024, wl + W_OUT, 1024, 1024, 1024, lds);
    transpose_job((const float*)inp(p, 20) + (size_t)l * 1024 * 5632, wl + W_UP, 1024, 5632, 5632, lds);
    transpose_job((const float*)inp(p, 23) + (size_t)l * 2816 * 1024, wl + W_DOWN, 2816, 1024, 1024, lds);
  }
  const int lane = otid() & 63, gw = blockIdx.x * 8 + (otid() >> 6), nw = gridDim.x * 8;
  float* bias = (float*)(wsp(p) + OFF_BIAS);
  for (int oi = gw; oi < 256; oi += nw) {
    const int l = oi >> 7, kv = (oi >> 6) & 1, e = oi & 63;
    const float* pos = (const float*)p.in[kv ? 11 : 10] + (size_t)l * 2048;
    const float* wt = (const float*)p.in[kv ? 13 : 12] + (size_t)l * 2048 * 64;
    float s = 0.f;
    for (int idx = lane; idx < 2048; idx += 64) s += pos[idx] * wt[(size_t)idx * 64 + e];
    s = wave_sum(s);
    if (lane == 0) bias[oi] = s;
  }
  rowpass_all((const float*)inp(p, 0), nullptr, nullptr, nullptr, (const float*)inp(p, 2), (u16*)(wsp(p) + OFF_H));
}


DI bool tile_mn(int j, int NT, int total, int& mt, int& nt) {
  const int i = blockIdx.x;
  const int lin = j * gridDim.x + (i & 7) * (gridDim.x >> 3) + (i >> 3);
  if (lin >= total) return false;
  mt = 4 * (lin / (4 * NT)) + (lin & 3);
  nt = (lin >> 2) % NT;
  return true;
}

DI void phaseA(const Params& p, int l, char* lds) {
  const u16* h = (const u16*)(wsp(p) + OFF_H);
  const u16* wt = (const u16*)wsp(p) + (size_t)l * W_LAYER + W_IN + (size_t)3072 * 1024;
  char* ws = wsp(p);
  bool pre = false;
  for (int j = 0; j * (int)gridDim.x < 128 * 14; ++j) {
    int mt, nt;
    if (!tile_mn(j, 14, 128 * 14, mt, nt)) continue;
    const int m0 = mt * 256, n0 = nt * 256;
    int mt2 = 0, nt2 = 0;
    const bool has_next = ((j + 1) * (int)gridDim.x < 128 * 14) && tile_mn(j + 1, 14, 128 * 14, mt2, nt2);
    f32x4m acc[2][2][4][2];
    zero_acc8(acc);
    gemm8_acc(h + (size_t)m0 * 1024, 1024, wt + (size_t)n0 * 1024, 1024, 1024, acc, lds, pre);
    if (has_next) gemm8_prologue(h + (size_t)(mt2 * 256) * 1024, 1024, wt + (size_t)(nt2 * 256) * 1024, 1024, lds);
    pre = has_next;
    epi8_apply(acc, m0, n0, [&](int m, int n, float v0, float v1, float v2, float v3) {
      const int b = m >> 13, s = m & (S - 1);
      if (n < 1536) {
        store_rows((u16*)(ws + OFF_P1A), 1536, m, n, v0, v1, v2, v3);
      } else if (n < 2208) {
        store_rows((u16*)(ws + OFF_P1B), 672, m, n - 1536, v0, v1, v2, v3);
      } else if (n < 2720) {
        const int c = n - 2208, hd = c >> 6, d = c & 63;
        store_rows((u16*)(ws + OFF_QN) + (size_t)(b * 8 + hd) * S * 64, 64, s, d, v0, v1, v2, v3);
      } else if (n < 3488) {
        const int seg = (n - 2720) >> 7;
        const int c = (n - 2720) & 127, g = c >> 6, d = c & 63;
        if (seg == 3 || seg == 5) {
          u16* dst = (u16*)(ws + (seg == 3 ? OFF_VST : OFF_VWT)) + ((size_t)((b * 2 + g) * 64 + d)) * S + permq(s);
          store_quad(dst, v0, v1, v2, v3);
        } else {
          const size_t off = seg == 0 ? OFF_KCMP : seg == 1 ? OFF_VCMP : seg == 2 ? OFF_KSLC : OFF_KWIN;
          store_rows((u16*)(ws + off) + (size_t)(b * 2 + g) * S * 64, 64, s, d, v0, v1, v2, v3);
        }
      } else if (n < N1) {
        float* gp = (float*)(ws + OFF_G) + (size_t)m * 24 + (n - 3488);
        gp[0] = v0; gp[24] = v1; gp[48] = v2; gp[72] = v3;
      }
    });
  }
}

struct TokRegs {
  u32x4 uc, ux, ub;
  unsigned cq[3];
  u32x2 ckv;
  int pos;
  u16 q1, q2, k1, k2, r1, r2;
};
DI void phaseB(const Params& p, int l) {
  const int lane = otid() & 63, gw = blockIdx.x * 8 + (otid() >> 6), nw = gridDim.x * 8;
  char* ws = wsp(p);
  const u16* P1A = (const u16*)(ws + OFF_P1A);
  u16* P1B = (u16*)(ws + OFF_P1B);
  const float* cw = (const float*)inp(p, 5) + (size_t)l * 3 * 512;
  const float* qn = (const float*)inp(p, 6) + (size_t)l * 384;
  const float* kvn = (const float*)inp(p, 8) + (size_t)l * 256;
  const int* posp = (const int*)inp(p, 1);
  const int c0 = lane * 8;
  float w[3][8];
#pragma unroll
  for (int k = 0; k < 3; ++k) {
    const f32x4 x0 = *(const f32x4*)(cw + k * 512 + c0), x1 = *(const f32x4*)(cw + k * 512 + c0 + 4);
    w[k][0] = x0.x; w[k][1] = x0.y; w[k][2] = x0.z; w[k][3] = x0.w; w[k][4] = x1.x; w[k][5] = x1.y; w[k][6] = x1.z; w[k][7] = x1.w;
  }
  float gq[6];
#pragma unroll
  for (int i = 0; i < 3; ++i) { gq[2 * i] = qn[lane * 2 + 128 * i]; gq[2 * i + 1] = qn[lane * 2 + 128 * i + 1]; }
  const f32x4 gkv = *(const f32x4*)(kvn + lane * 4);
  const int ri = lane & 7;
  const int ktn = lane >> 4, kg = (lane >> 3) & 1;
  const size_t koffb = ktn == 0 ? OFF_KCMP : ktn == 1 ? OFF_KSLC : OFF_KWIN;
  auto qptr = [&](int b, int s) { return (u16*)(ws + OFF_QN) + ((size_t)(b * 8 + (lane >> 3)) * S + s) * 64 + ri; };
  auto kptr = [&](int b, int s) { return (u16*)(ws + koffb) + ((size_t)(b * 2 + kg) * S + s) * 64 + ri; };
  auto loads = [&](int t, TokRegs& g) {
    const int b = t >> 13, s = t & (S - 1);
    const u16* row = P1A + (size_t)t * 1536;
    g.ub = __builtin_nontemporal_load((const u32x4*)(row + c0));
    g.uc = __builtin_nontemporal_load((const u32x4*)(row + 512 + c0));
    g.ux = __builtin_nontemporal_load((const u32x4*)(row + 1024 + c0));
    const u16* pb = P1B + (size_t)t * 672;
#pragma unroll
    for (int i = 0; i < 3; ++i) g.cq[i] = *(const unsigned*)(pb + lane * 2 + 128 * i);
    g.ckv = *(const u32x2*)(pb + 384 + lane * 4);
    g.pos = posp[t];
    const u16* q = qptr(b, s);
    g.q1 = q[0]; g.q2 = q[8];
    g.k1 = 0; g.k2 = 0; g.r1 = 0; g.r2 = 0;
    if (lane < 48) { const u16* k = kptr(b, s); g.k1 = k[0]; g.k2 = k[8]; }
    if (lane < 16) { g.r1 = pb[640 + lane]; g.r2 = pb[656 + lane]; }
  };
  constexpr int RUN = 16;
  for (int run = gw; run < T / RUN; run += nw) {
    const int t0 = run * RUN, s0 = t0 & (S - 1);
    float um2[8], um1[8];
#pragma unroll
    for (int j = 0; j < 8; ++j) { um2[j] = 0.f; um1[j] = 0.f; }
    if (s0 > 0) {
      const u16* r2 = P1A + (size_t)(t0 - 2) * 1536;
      const u16* r1 = P1A + (size_t)(t0 - 1) * 1536;
      const u32x4 c2 = *(const u32x4*)(r2 + 512 + c0), x2 = *(const u32x4*)(r2 + 1024 + c0);
      const u32x4 c1 = *(const u32x4*)(r1 + 512 + c0), x1 = *(const u32x4*)(r1 + 1024 + c0);
      um2[0] = bflo(c2.x) * bflo(x2.x); um2[1] = bfhi(c2.x) * bfhi(x2.x); um2[2] = bflo(c2.y) * bflo(x2.y); um2[3] = bfhi(c2.y) * bfhi(x2.y);
      um2[4] = bflo(c2.z) * bflo(x2.z); um2[5] = bfhi(c2.z) * bfhi(x2.z); um2[6] = bflo(c2.w) * bflo(x2.w); um2[7] = bfhi(c2.w) * bfhi(x2.w);
      um1[0] = bflo(c1.x) * bflo(x1.x); um1[1] = bfhi(c1.x) * bfhi(x1.x); um1[2] = bflo(c1.y) * bflo(x1.y); um1[3] = bfhi(c1.y) * bfhi(x1.y);
      um1[4] = bflo(c1.z) * bflo(x1.z); um1[5] = bfhi(c1.z) * bfhi(x1.z); um1[6] = bflo(c1.w) * bflo(x1.w); um1[7] = bfhi(c1.w) * bfhi(x1.w);
    }
    TokRegs cur, nxt;
    loads(t0, cur);
    for (int tt = 0; tt < RUN; ++tt) {
      const int t = t0 + tt, b = t >> 13, s = t & (S - 1);
      if (tt + 1 < RUN) loads(t + 1, nxt);
      {
        const float cc[8] = {bflo(cur.uc.x), bfhi(cur.uc.x), bflo(cur.uc.y), bfhi(cur.uc.y), bflo(cur.uc.z), bfhi(cur.uc.z), bflo(cur.uc.w), bfhi(cur.uc.w)};
        const float cx[8] = {bflo(cur.ux.x), bfhi(cur.ux.x), bflo(cur.ux.y), bfhi(cur.ux.y), bflo(cur.ux.z), bfhi(cur.ux.z), bflo(cur.ux.w), bfhi(cur.ux.w)};
        const float cb[8] = {bflo(cur.ub.x), bfhi(cur.ub.x), bflo(cur.ub.y), bfhi(cur.ub.y), bflo(cur.ub.z), bfhi(cur.ub.z), bflo(cur.ub.w), bfhi(cur.ub.w)};
        float y[8];
#pragma unroll
        for (int j = 0; j < 8; ++j) {
          const float u0 = cc[j] * cx[j];
          y[j] = cb[j] * (w[0][j] * um2[j] + w[1][j] * um1[j] + w[2][j] * u0);
          um2[j] = um1[j];
          um1[j] = u0;
        }
        *(u32x4*)((u16*)(ws + OFF_YCONV) + (size_t)t * 512 + c0) = mk_u4(pack2(y[0], y[1]), pack2(y[2], y[3]), pack2(y[4], y[5]), pack2(y[6], y[7]));
      }
      u16* pb = P1B + (size_t)t * 672;
      {
        float v[6];
#pragma unroll
        for (int i = 0; i < 3; ++i) { v[2 * i] = bflo(cur.cq[i]); v[2 * i + 1] = bfhi(cur.cq[i]); }
        const float k0 = bflo(cur.ckv.x), k1 = bfhi(cur.ckv.x), k2 = bflo(cur.ckv.y), k3 = bfhi(cur.ckv.y);
        float s1 = v[0] * v[0] + v[1] * v[1] + v[2] * v[2] + v[3] * v[3] + v[4] * v[4] + v[5] * v[5];
        float s2 = k0 * k0 + k1 * k1 + k2 * k2 + k3 * k3;
#pragma unroll
        for (int off = 32; off > 0; off >>= 1) { s1 += __shfl_xor(s1, off, 64); s2 += __shfl_xor(s2, off, 64); }
        const float rs1 = rsqrtf(s1 * (1.f / 384.f) + 1e-6f), rs2 = rsqrtf(s2 * (1.f / 256.f) + 1e-6f);
#pragma unroll
        for (int i = 0; i < 3; ++i) *(unsigned*)(pb + lane * 2 + 128 * i) = pack2(v[2 * i] * rs1 * gq[2 * i], v[2 * i + 1] * rs1 * gq[2 * i + 1]);
        u32x2 o;
        o.x = pack2(k0 * rs2 * gkv.x, k1 * rs2 * gkv.y);
        o.y = pack2(k2 * rs2 * gkv.z, k3 * rs2 * gkv.w);
        *(u32x2*)(pb + 384 + lane * 4) = o;
      }
      {
        float c, sn;
        sincos_pos(cur.pos, INVF[2 * ri], c, sn);
        {
          u16* q = qptr(b, s);
          const float x1 = bf2f(cur.q1), x2 = bf2f(cur.q2);
          q[0] = f2bf(x1 * c - x2 * sn);
          q[8] = f2bf(x2 * c + x1 * sn);
        }
        if (lane < 48) {
          u16* k = kptr(b, s);
          const float x1 = bf2f(cur.k1), x2 = bf2f(cur.k2);
          k[0] = f2bf(x1 * c - x2 * sn);
          k[8] = f2bf(x2 * c + x1 * sn);
        }
      }
      if (lane < 16) {
        float c, sn;
        sincos_pos(cur.pos, INVF[lane], c, sn);
        const float x1 = bf2f(cur.r1), x2 = bf2f(cur.r2);
        const u16 r1 = f2bf(x1 * c - x2 * sn), r2 = f2bf(x2 * c + x1 * sn);
#pragma unroll
        for (int hd = 0; hd < 8; ++hd) {
          u16* k = (u16*)(ws + OFF_KMLA) + ((size_t)(b * 8 + hd) * S + s) * 96;
          k[64 + lane] = r1;
          k[80 + lane] = r2;
        }
      }
      cur = nxt;
    }
  }
}

DI void phaseC(const Params& p, int l, char* lds) {
  char* ws = wsp(p);
  const u16* wl = (const u16*)wsp(p) + (size_t)l * W_LAYER;
  const u16* P1B = (const u16*)(wsp(p) + OFF_P1B);
  const float* bias = (const float*)(wsp(p) + OFF_BIAS) + l * 128;
  constexpr int NT_Q = 128 * 6, NT_KV = 128 * 4, NT_C = 32;
  for (int tile0 = blockIdx.x; tile0 < NT_KV + NT_Q + NT_C; tile0 += gridDim.x) {
    const int tile = tile0 < NT_C ? NT_KV + NT_Q + tile0 : tile0 - NT_C;
    if (tile < NT_KV) {
      const int mt = tile >> 2, nt = tile & 3;
      const int m0 = mt * 256, n0 = nt * 256;
      f32x16 acc[4][2];
      zero_acc<2>(acc);
      gemm_acc<2>(P1B + (size_t)m0 * 672 + 384, 672, wl + W_UKV + (size_t)n0 * 256, 256, 256, acc, lds);
      epi_apply<2>(acc, m0, n0, [&](int m, int n, float v0, float v1, float v2, float v3) {
        const int b = m >> 13, s = m & (S - 1), hd = n >> 7, c = n & 127;
        if (c < 64) {
          store_rows((u16*)(ws + OFF_KMLA) + (size_t)(b * 8 + hd) * S * 96, 96, s, c, v0, v1, v2, v3);
        } else {
          u16* dst = (u16*)(ws + OFF_VTMLA) + ((size_t)((b * 8 + hd) * 64 + (c - 64))) * S + permq(s);
          store_quad(dst, v0, v1, v2, v3);
        }
      });
    } else if (tile < NT_KV + NT_Q) {
      const int t2 = tile - NT_KV;
      const int mt = t2 / 6, nt = t2 % 6;
      const int m0 = mt * 256, n0 = nt * 128;
      f32x16 acc[4][1];
      zero_acc<1>(acc);
      gemm_acc<1>(P1B + (size_t)m0 * 672, 672, wl + W_UQ + (size_t)n0 * 384, 384, 384, acc, lds);
      epi_apply<1>(acc, m0, n0, [&](int m, int n, float v0, float v1, float v2, float v3) {
        const int b = m >> 13, s = m & (S - 1), hd = n / 96, c = n % 96;
        store_rows((u16*)(ws + OFF_QMLA) + (size_t)(b * 8 + hd) * S * 96, 96, s, c, v0, v1, v2, v3);
      });
    } else {
      const int t2 = tile - NT_KV - NT_Q;
      const int kv = t2 >> 4, slab = (t2 >> 1) & 7, mt = t2 & 1;
      const u16* Ab = (const u16*)(ws + (kv ? OFF_VCMP : OFF_KCMP)) + (size_t)slab * S * 64 + (size_t)(mt * 256) * 1024;
      f32x16 acc[4][1];
      zero_acc<1>(acc);
      gemm_acc<1>(Ab, 1024, wl + (kv ? W_CV : W_CK), 2048, 2048, acc, lds);
      const float* bs = bias + kv * 64;
      epi_apply<1>(acc, mt * 256, 0, [&](int m, int n, float v0, float v1, float v2, float v3) {
        if (n >= 64) return;
        const float bb = bs[n];
        v0 += bb; v1 += bb; v2 += bb; v3 += bb;
        if (m + 3 >= 511) v3 = 0.f;
        if (kv == 0) {
          store_rows((u16*)(ws + OFF_KC) + (size_t)slab * 512 * 64, 64, m, n, v0, v1, v2, v3);
        } else {
          u16* dst = (u16*)(ws + OFF_VCT) + ((size_t)(slab * 64 + n)) * 512 + permq(m);
          store_quad(dst, v0, v1, v2, v3);
        }
      });
    }
  }
}

constexpr float C_MLA = 0.14724444602590306f;
constexpr float C_NSA = 0.18033688011112042f;

DI bf16x8 pack8(const f32x16& x, int s2) {
  u32x4 u;
  u.x = pack2(x[8 * s2 + 0], x[8 * s2 + 1]);
  u.y = pack2(x[8 * s2 + 2], x[8 * s2 + 3]);
  u.z = pack2(x[8 * s2 + 4], x[8 * s2 + 5]);
  u.w = pack2(x[8 * s2 + 6], x[8 * s2 + 7]);
  return __builtin_bit_cast(bf16x8, u);
}
DI bf16x8 frag128(const char* base, int row, int chunk) { return *(const bf16x8*)(base + row * 128 + ((chunk ^ ((row >> 1) & 7)) << 4)); }
DI bf16x8 frag256(const char* base, int row, int chunk) { return *(const bf16x8*)(base + row * 256 + ((chunk ^ (row & 15)) << 4)); }

template <bool MASKED>
DI void softmax_step(f32x16 (&sc)[2], const float C, float& m, float& lsum, f32x16 (&o)[2], int kbase, int lo, int hi, bool lane_on, int hh,
                     const bf16x8 (&vf)[2][2][2]) {
  float mx;
  if (MASKED) {
    mx = -1e30f;
#pragma unroll
    for (int kb = 0; kb < 2; ++kb)
#pragma unroll
      for (int i = 0; i < 16; ++i) {
        const int key = kbase + 32 * kb + crow(i, hh);
        mx = fmaxf(mx, (key <= hi && key > lo) ? sc[kb][i] : -1e30f);
      }
  } else {
    float a0 = fmaxf(fmaxf(sc[0][0], sc[0][1]), sc[0][2]);
    float a1 = fmaxf(fmaxf(sc[1][0], sc[1][1]), sc[1][2]);
#pragma unroll
    for (int i = 3; i < 15; i += 2) {
      a0 = fmaxf(fmaxf(a0, sc[0][i]), sc[0][i + 1]);
      a1 = fmaxf(fmaxf(a1, sc[1][i]), sc[1][i + 1]);
    }
    mx = fmaxf(fmaxf(a0, a1), fmaxf(sc[0][15], sc[1][15]));
  }
  if (!lane_on) mx = -1e30f;
  mx = fmaxf(mx, __shfl_xor(mx, 32, 64));
  if (__any((mx - m) * C > 8.f)) {
    const float mn = fmaxf(m, mx);
    const float alpha = __builtin_amdgcn_exp2f((m - mn) * C);
    m = mn;
    lsum *= alpha;
    o[0] = o[0] * alpha;
    o[1] = o[1] * alpha;
  }
  const float mc = lane_on ? m * C : 3e38f;
  f32x16 t0 = sc[0] * C - mc;
#pragma unroll
  for (int i = 0; i < 16; ++i) t0[i] = __builtin_amdgcn_exp2f(t0[i]);
  if (MASKED) {
#pragma unroll
    for (int i = 0; i < 16; ++i) {
      const int key0 = kbase + crow(i, hh);
      t0[i] = (key0 <= hi && key0 > lo) ? t0[i] : 0.f;
    }
  }
#pragma unroll
  for (int s2 = 0; s2 < 2; ++s2) {
    const bf16x8 pb = pack8(t0, s2);
#pragma unroll
    for (int dvb = 0; dvb < 2; ++dvb) o[dvb] = MFMA(vf[0][s2][dvb], pb, o[dvb]);
  }
  f32x16 t1 = sc[1] * C - mc;
#pragma unroll
  for (int i = 0; i < 16; ++i) t1[i] = __builtin_amdgcn_exp2f(t1[i]);
  if (MASKED) {
#pragma unroll
    for (int i = 0; i < 16; ++i) {
      const int key1 = kbase + 32 + crow(i, hh);
      t1[i] = (key1 <= hi && key1 > lo) ? t1[i] : 0.f;
    }
  }
#pragma unroll
  for (int s2 = 0; s2 < 2; ++s2) {
    const bf16x8 pb = pack8(t1, s2);
#pragma unroll
    for (int dvb = 0; dvb < 2; ++dvb) o[dvb] = MFMA(vf[1][s2][dvb], pb, o[dvb]);
  }
  const f32x16 sv = t0 + t1;
  typedef float f32x8 __attribute__((ext_vector_type(8)));
  typedef float f32x4v __attribute__((ext_vector_type(4)));
  typedef float f32x2v __attribute__((ext_vector_type(2)));
  const f32x8 s8 = __builtin_shufflevector(sv, sv, 0, 1, 2, 3, 4, 5, 6, 7) + __builtin_shufflevector(sv, sv, 8, 9, 10, 11, 12, 13, 14, 15);
  const f32x4v s4 = __builtin_shufflevector(s8, s8, 0, 1, 2, 3) + __builtin_shufflevector(s8, s8, 4, 5, 6, 7);
  const f32x2v s2 = __builtin_shufflevector(s4, s4, 0, 1) + __builtin_shufflevector(s4, s4, 2, 3);
  lsum += s2[0] + s2[1];
}

DI void mla_tile(const Params& p, int tile, char* lds) {
  const int tid = otid(), lane = tid & 63, w = tid >> 6, r = lane & 31, hh = lane >> 5;
  const int qt = 31 - (tile >> 5), bh = tile & 31, b = bh >> 3, hd = bh & 7;
  const int q0 = qt * 256, qw0 = q0 + 32 * w, q = qw0 + r;
  bf16x8 qf[6];
  {
    const u16* Qp = (const u16*)(wsp(p) + OFF_QMLA) + ((size_t)bh * S + q) * 96 + 8 * hh;
#pragma unroll
    for (int s = 0; s < 6; ++s) qf[s] = *(const bf16x8*)(Qp + 16 * s);
    const int pos = ((const int*)inp(p, 1))[b * S + q];
#pragma unroll
    for (int j = 0; j < 8; ++j) {
      float c, sn;
      sincos_pos(pos, INVF[8 * hh + j], c, sn);
      const float x1 = bf2f((u16)qf[4][j]), x2 = bf2f((u16)qf[5][j]);
      qf[4][j] = (short)f2bf(x1 * c - x2 * sn);
      qf[5][j] = (short)f2bf(x2 * c + x1 * sn);
    }
  }
  const u16* Kg = (const u16*)(wsp(p) + OFF_KMLA) + (size_t)bh * S * 96;
  const u16* Vg = (const u16*)(wsp(p) + OFF_VTMLA) + (size_t)bh * 64 * S;
  int koff[2], voff;
#pragma unroll
  for (int i = 0; i < 2; ++i) {
    const int id = tid + 512 * i, row = id / 12, c = id % 12;
    koff[i] = row * 256 + ((c ^ (row & 15)) << 4);
  }
  {
    const int row = tid >> 3, c = tid & 7;
    voff = 16384 + row * 128 + ((c ^ ((row >> 1) & 7)) << 4);
  }
  u32x4 rk[2], rv;
  auto gload = [&](int kt) {
    rk[0] = *(const u32x4*)(Kg + (size_t)kt * 64 * 96 + (size_t)tid * 8);
    if (tid < 256) rk[1] = *(const u32x4*)(Kg + (size_t)kt * 64 * 96 + (size_t)(tid + 512) * 8);
    rv = *(const u32x4*)(Vg + (size_t)(tid >> 3) * S + kt * 64 + (tid & 7) * 8);
  };
  f32x16 o[2];
  o[0] = zero16(); o[1] = zero16();
  float m = -1e30f, lsum = 0.f;
  const int nkt = 4 * qt + 4;
  gload(0);
  for (int kt = 0; kt < nkt; ++kt) {
    char* st = lds + (kt & 1) * 24576;
    *(u32x4*)(st + koff[0]) = rk[0];
    if (tid < 256) *(u32x4*)(st + koff[1]) = rk[1];
    *(u32x4*)(st + voff) = rv;
    __syncthreads();
    if (kt + 1 < nkt) gload(kt + 1);
    const int k0 = kt * 64;
    if (k0 <= qw0 + 31) {
      f32x16 sc[2];
      {
        bf16x8 kf[2][6];
#pragma unroll
        for (int kb = 0; kb < 2; ++kb)
#pragma unroll
          for (int s = 0; s < 6; ++s) kf[kb][s] = frag256(st, 32 * kb + r, 2 * s + hh);
        asm volatile("" ::: "memory");
#pragma unroll
        for (int kb = 0; kb < 2; ++kb) {
          sc[kb] = zero16();
#pragma unroll
          for (int s = 0; s < 6; ++s) sc[kb] = MFMA(kf[kb][s], qf[s], sc[kb]);
        }
      }
      bf16x8 vf[2][2][2];
#pragma unroll
      for (int kb = 0; kb < 2; ++kb)
#pragma unroll
        for (int s2 = 0; s2 < 2; ++s2)
#pragma unroll
          for (int dvb = 0; dvb < 2; ++dvb) vf[kb][s2][dvb] = frag128(st + 16384, 32 * dvb + r, 4 * kb + 2 * s2 + hh);
      asm volatile("" ::: "memory");
      if (k0 + 63 > qw0) softmax_step<true>(sc, C_MLA, m, lsum, o, k0, -1, q, true, hh, vf);
      else softmax_step<false>(sc, C_MLA, m, lsum, o, k0, -1, q, true, hh, vf);
    }
  }
  __syncthreads();
  lsum += __shfl_xor(lsum, 32, 64);
  const float inv = 1.f / lsum;
  u16* yo = (u16*)(wsp(p) + OFF_YMLA) + (size_t)(b * S + q) * 512 + hd * 64;
#pragma unroll
  for (int dvb = 0; dvb < 2; ++dvb)
#pragma unroll
    for (int g4 = 0; g4 < 4; ++g4)
      store_quad(yo + 32 * dvb + 8 * g4 + 4 * hh, o[dvb][4 * g4] * inv, o[dvb][4 * g4 + 1] * inv, o[dvb][4 * g4 + 2] * inv, o[dvb][4 * g4 + 3] * inv);
}

struct KVRegs { u32x4 k, v; };
DI void kv_gload(KVRegs& rg, const u16* Kg, const u16* Vg, size_t vld, int kt, int tid, bool with_v) {
  rg.k = *(const u32x4*)(Kg + (size_t)kt * 4096 + (size_t)tid * 8);
  if (with_v) rg.v = *(const u32x4*)(Vg + (size_t)(tid >> 3) * vld + kt * 64 + (tid & 7) * 8);
}
DI void kv_store(const KVRegs& rg, char* st, int tid, bool with_v) {
  const int row = tid >> 3, c = tid & 7;
  const int off = row * 128 + ((c ^ ((row >> 1) & 7)) << 4);
  *(u32x4*)(st + off) = rg.k;
  if (with_v) *(u32x4*)(st + 8192 + off) = rg.v;
}

DI void cmp_tile(const Params& p, int tile, char* lds) {
  const int tid = otid(), lane = tid & 63, w = tid >> 6, r = lane & 31, hh = lane >> 5;
  const int slab = tile & 7, qt = 127 - (tile >> 3), b = slab >> 1, g = slab & 1;
  const int q0 = qt * 64, tl = 8 * w + (r >> 2), tok = q0 + tl, head = g * 4 + (r & 3);
  bf16x8 qf[4];
  {
    const u16* Qp = (const u16*)(wsp(p) + OFF_QN) + ((size_t)(b * 8 + head) * S + tok) * 64 + 8 * hh;
#pragma unroll
    for (int s = 0; s < 4; ++s) qf[s] = *(const bf16x8*)(Qp + 16 * s);
  }
  float* imp = (float*)(lds + 32768);
#pragma unroll
  for (int i = 0; i < 16; ++i) imp[tid + 512 * i] = 0.f;
  const u16* Kg = (const u16*)(wsp(p) + OFF_KC) + (size_t)slab * 512 * 64;
  const u16* Vg = (const u16*)(wsp(p) + OFF_VCT) + (size_t)slab * 64 * 512;
  const int nkt = ((q0 + 32) >> 10) + 1;
  const int lim = tok - 31;
  KVRegs rg;
  float m = -1e30f, lsum = 0.f;
  kv_gload(rg, Kg, Vg, 512, 0, tid, false);
  for (int kt = 0; kt < nkt; ++kt) {
    char* st = lds + (kt & 1) * 16384;
    kv_store(rg, st, tid, false);
    __syncthreads();
    if (kt + 1 < nkt) kv_gload(rg, Kg, Vg, 512, kt + 1, tid, false);
    f32x16 sc[2];
#pragma unroll
    for (int kb = 0; kb < 2; ++kb) {
      sc[kb] = zero16();
#pragma unroll
      for (int s = 0; s < 4; ++s) sc[kb] = MFMA(frag128(st, 32 * kb + r, 2 * s + hh), qf[s], sc[kb]);
    }
    float mx = -1e30f;
#pragma unroll
    for (int kb = 0; kb < 2; ++kb)
#pragma unroll
      for (int i = 0; i < 16; ++i) {
        const int n = kt * 64 + 32 * kb + crow(i, hh);
        mx = fmaxf(mx, (16 * n <= lim) ? sc[kb][i] : -1e30f);
      }
    mx = fmaxf(mx, __shfl_xor(mx, 32, 64));
    const float mn = fmaxf(m, mx);
    const float alpha = __builtin_amdgcn_exp2f((m - mn) * C_NSA);
    m = mn;
    const float mc = mn * C_NSA;
    float rs = 0.f;
#pragma unroll
    for (int kb = 0; kb < 2; ++kb)
#pragma unroll
      for (int i = 0; i < 16; ++i) {
        const int n = kt * 64 + 32 * kb + crow(i, hh);
        const float pv = __builtin_amdgcn_exp2f(sc[kb][i] * C_NSA - mc);
        rs += (16 * n <= lim) ? pv : 0.f;
      }
    lsum = lsum * alpha + rs;
  }
  __syncthreads();
  lsum += __shfl_xor(lsum, 32, 64);
  const float invl = lsum > 0.f ? 1.f / lsum : 0.f;
  const float mc = m * C_NSA;
  f32x16 o[2];
  o[0] = zero16(); o[1] = zero16();
  float carry = 0.f;
  kv_gload(rg, Kg, Vg, 512, 0, tid, true);
  for (int kt = 0; kt < nkt; ++kt) {
    char* st = lds + (kt & 1) * 16384;
    kv_store(rg, st, tid, true);
    __syncthreads();
    if (kt + 1 < nkt) kv_gload(rg, Kg, Vg, 512, kt + 1, tid, true);
    f32x16 sc[2];
#pragma unroll
    for (int kb = 0; kb < 2; ++kb) {
      sc[kb] = zero16();
#pragma unroll
      for (int s = 0; s < 4; ++s) sc[kb] = MFMA(frag128(st, 32 * kb + r, 2 * s + hh), qf[s], sc[kb]);
    }
#pragma unroll
    for (int kb = 0; kb < 2; ++kb) {
#pragma unroll
      for (int i = 0; i < 16; ++i) {
        const int n = kt * 64 + 32 * kb + crow(i, hh);
        const float pv = __builtin_amdgcn_exp2f(sc[kb][i] * C_NSA - mc) * invl;
        sc[kb][i] = (16 * n <= lim) ? pv : 0.f;
      }
      float qs[4], ls[4], rc[4];
#pragma unroll
      for (int g4 = 0; g4 < 4; ++g4) {
        qs[g4] = (sc[kb][4 * g4] + sc[kb][4 * g4 + 1]) + (sc[kb][4 * g4 + 2] + sc[kb][4 * g4 + 3]);
        ls[g4] = sc[kb][4 * g4 + 3];
        qs[g4] += __shfl_xor(qs[g4], 1, 64);
        qs[g4] += __shfl_xor(qs[g4], 2, 64);
        ls[g4] += __shfl_xor(ls[g4], 1, 64);
        ls[g4] += __shfl_xor(ls[g4], 2, 64);
      }
#pragma unroll
      for (int g4 = 0; g4 < 4; ++g4) rc[g4] = __shfl_xor(ls[g4], 32, 64);
#pragma unroll
      for (int g4 = 0; g4 < 4; ++g4) {
        const float prev = (g4 > 0) ? rc[g4 > 0 ? g4 - 1 : 0] : carry;
        const float val = qs[g4] + (hh ? rc[g4] : prev);
        const int Q = 16 * kt + 8 * kb + 2 * g4 + hh;
        if ((r & 3) == 0) imp[tl * 128 + Q] = val;
      }
      carry = rc[3];
    }
#pragma unroll
    for (int kb = 0; kb < 2; ++kb)
#pragma unroll
      for (int s2 = 0; s2 < 2; ++s2) {
        const bf16x8 pb = pack8(sc[kb], s2);
#pragma unroll
        for (int dvb = 0; dvb < 2; ++dvb) o[dvb] = MFMA(frag128(st + 8192, 32 * dvb + r, 4 * kb + 2 * s2 + hh), pb, o[dvb]);
      }
  }
  __syncthreads();
  {
    const float g0 = sigmoidf_(((const float*)(wsp(p) + OFF_G))[(size_t)(b * S + tok) * 24 + head * 3]);
    u16* yo = (u16*)(wsp(p) + OFF_YNSA) + (size_t)(b * S + tok) * 512 + head * 64;
#pragma unroll
    for (int dvb = 0; dvb < 2; ++dvb)
#pragma unroll
      for (int g4 = 0; g4 < 4; ++g4)
        store_quad(yo + 32 * dvb + 8 * g4 + 4 * hh, o[dvb][4 * g4] * g0, o[dvb][4 * g4 + 1] * g0, o[dvb][4 * g4 + 2] * g0, o[dvb][4 * g4 + 3] * g0);
  }
  float* vals = (float*)(lds + 65536) + w * 128;
  for (int tt = 0; tt < 8; ++tt) {
    const int tl2 = 8 * w + tt, tok2 = q0 + tl2, cur = tok2 >> 6;
    const int m1 = lane, m2 = lane + 64;
    const float v1 = (m1 == 0 || m1 == cur || m1 == cur - 1) ? 1e6f : (m1 <= cur ? imp[tl2 * 128 + m1] : -1.f);
    const float v2 = (m2 == cur || m2 == cur - 1) ? 1e6f : (m2 <= cur ? imp[tl2 * 128 + m2] : -1.f);
    vals[m1] = v1;
    vals[m2] = v2;
    asm volatile("s_waitcnt lgkmcnt(0)" ::: "memory");
    int c1 = 0, c2 = 128;
    if (cur >= 64) {
      c2 = 0;
      for (int j = 0; j <= cur; j += 4) {
        const f32x4 vj = *(const f32x4*)(vals + j);
        c1 += (vj.x > v1 || (vj.x == v1 && j < m1)) ? 1 : 0;
        c1 += (vj.y > v1 || (vj.y == v1 && j + 1 < m1)) ? 1 : 0;
        c1 += (vj.z > v1 || (vj.z == v1 && j + 2 < m1)) ? 1 : 0;
        c1 += (vj.w > v1 || (vj.w == v1 && j + 3 < m1)) ? 1 : 0;
        c2 += (vj.x > v2 || (vj.x == v2 && j < m2)) ? 1 : 0;
        c2 += (vj.y > v2 || (vj.y == v2 && j + 1 < m2)) ? 1 : 0;
        c2 += (vj.z > v2 || (vj.z == v2 && j + 2 < m2)) ? 1 : 0;
        c2 += (vj.w > v2 || (vj.w == v2 && j + 3 < m2)) ? 1 : 0;
      }
    } else {
      for (int j = 0; j <= cur; j += 4) {
        const f32x4 vj = *(const f32x4*)(vals + j);
        c1 += (vj.x > v1 || (vj.x == v1 && j < m1)) ? 1 : 0;
        c1 += (vj.y > v1 || (vj.y == v1 && j + 1 < m1)) ? 1 : 0;
        c1 += (vj.z > v1 || (vj.z == v1 && j + 2 < m1)) ? 1 : 0;
        c1 += (vj.w > v1 || (vj.w == v1 && j + 3 < m1)) ? 1 : 0;
      }
    }
    const unsigned long long b1 = __ballot(c1 < 16 && v1 >= 0.f);
    const unsigned long long b2 = __ballot(c2 < 16 && v2 >= 0.f);
    if (lane == 0)
      *(u32x4*)(wsp(p) + OFF_SEL + ((size_t)slab * S + tok2) * 16) = mk_u4((unsigned)b1, (unsigned)(b1 >> 32), (unsigned)b2, (unsigned)(b2 >> 32));
    asm volatile("s_waitcnt lgkmcnt(0)" ::: "memory");
  }
  __syncthreads();
}

DI void nsa_tile(const Params& p, int tile, char* lds) {
  const int tid = otid(), lane = tid & 63, w = tid >> 6, r = lane & 31, hh = lane >> 5;
  const int slab = tile & 7, qt = 127 - (tile >> 3), b = slab >> 1, g = slab & 1;
  const int q0 = qt * 64, tl = 8 * w + (r >> 2), tok = q0 + tl, head = g * 4 + (r & 3);
  bf16x8 qf[4];
  {
    const u16* Qp = (const u16*)(wsp(p) + OFF_QN) + ((size_t)(b * 8 + head) * S + tok) * 64 + 8 * hh;
#pragma unroll
    for (int s = 0; s < 4; ++s) qf[s] = *(const bf16x8*)(Qp + 16 * s);
  }
  const u32x4 sm = *(const u32x4*)(wsp(p) + OFF_SEL + ((size_t)slab * S + tok) * 16);
  const float* gp = (const float*)(wsp(p) + OFF_G) + (size_t)(b * S + tok) * 24 + head * 3;
  f32x16 outa[2];
  outa[0] = zero16(); outa[1] = zero16();
  KVRegs rg;
  for (int mode = 0; mode < 2; ++mode) {
    const u16* Kg = (const u16*)(wsp(p) + (mode ? OFF_KWIN : OFF_KSLC)) + (size_t)slab * S * 64;
    const u16* Vg = (const u16*)(wsp(p) + (mode ? OFF_VWT : OFF_VST)) + (size_t)slab * 64 * S;
    const int kt_lo = mode ? ((q0 > 511 ? q0 - 511 : 0) >> 6) : 0;
    const int kt_hi = q0 >> 6;
    const int lo = mode ? tok - 512 : -1;
    f32x16 o[2];
    o[0] = zero16(); o[1] = zero16();
    float m = -1e30f, lsum = 0.f;
    kv_gload(rg, Kg, Vg, S, kt_lo, tid, true);
    for (int kt = kt_lo; kt <= kt_hi; ++kt) {
      char* st = lds + ((kt - kt_lo) & 1) * 16384;
      kv_store(rg, st, tid, true);
      __syncthreads();
      if (kt < kt_hi) kv_gload(rg, Kg, Vg, S, kt + 1, tid, true);
      const unsigned word = kt < 32 ? sm.x : kt < 64 ? sm.y : kt < 96 ? sm.z : sm.w;
      const bool bit = mode ? true : (((word >> (kt & 31)) & 1u) != 0);
      if (__ballot(bit) != 0ull) {
        const int k0 = kt * 64;
        f32x16 sc[2];
        {
          bf16x8 kf[2][4];
#pragma unroll
          for (int kb = 0; kb < 2; ++kb)
#pragma unroll
            for (int s = 0; s < 4; ++s) kf[kb][s] = frag128(st, 32 * kb + r, 2 * s + hh);
          asm volatile("" ::: "memory");
#pragma unroll
          for (int kb = 0; kb < 2; ++kb) {
            sc[kb] = zero16();
#pragma unroll
            for (int s = 0; s < 4; ++s) sc[kb] = MFMA(kf[kb][s], qf[s], sc[kb]);
          }
        }
        bf16x8 vf[2][2][2];
#pragma unroll
        for (int kb = 0; kb < 2; ++kb)
#pragma unroll
          for (int s2 = 0; s2 < 2; ++s2)
#pragma unroll
            for (int dvb = 0; dvb < 2; ++dvb) vf[kb][s2][dvb] = frag128(st + 8192, 32 * dvb + r, 4 * kb + 2 * s2 + hh);
        asm volatile("" ::: "memory");
        const bool need_mask = (k0 + 63 > q0 + 8 * w) || (mode && k0 <= q0 + 8 * w + 7 - 512);
        if (need_mask) softmax_step<true>(sc, C_NSA, m, lsum, o, k0, lo, tok, bit, hh, vf);
        else softmax_step<false>(sc, C_NSA, m, lsum, o, k0, lo, tok, bit, hh, vf);
      }
    }
    __syncthreads();
    lsum += __shfl_xor(lsum, 32, 64);
    const float gate = sigmoidf_(gp[1 + mode]);
    const float sc_ = lsum > 0.f ? gate / lsum : 0.f;
#pragma unroll
    for (int i = 0; i < 16; ++i) { outa[0][i] += o[0][i] * sc_; outa[1][i] += o[1][i] * sc_; }
  }
  u16* yo = (u16*)(wsp(p) + OFF_YNSA) + (size_t)(b * S + tok) * 512 + head * 64;
#pragma unroll
  for (int dvb = 0; dvb < 2; ++dvb)
#pragma unroll
    for (int g4 = 0; g4 < 4; ++g4) {
      u16* d = yo + 32 * dvb + 8 * g4 + 4 * hh;
      const u32x2 pc = *(const u32x2*)d;
      store_quad(d, outa[dvb][4 * g4] + bflo(pc.x), outa[dvb][4 * g4 + 1] + bfhi(pc.x), outa[dvb][4 * g4 + 2] + bflo(pc.y), outa[dvb][4 * g4 + 3] + bfhi(pc.y));
    }
}

DI void phaseF(const Params& p, int l, char* lds) {
  const u16* wl = (const u16*)wsp(p) + (size_t)l * W_LAYER;
  const u16* h = (const u16*)(wsp(p) + OFF_H);
  u16* merged = (u16*)(wsp(p) + OFF_MERGED);
  int pre = -1;
  for (int j = 0; j * (int)gridDim.x < 128 * 8; ++j) {
    int mt, nt;
    if (!tile_mn(j, 8, 128 * 8, mt, nt)) continue;
    int mt2 = 0, nt2 = 0;
    const bool has_next = ((j + 1) * (int)gridDim.x < 128 * 8) && tile_mn(j + 1, 8, 128 * 8, mt2, nt2);
    const int m0 = mt * 256, n0 = nt * 128;
    unsigned fpk[4][8];
#pragma unroll
    for (int mi = 0; mi < 4; ++mi)
#pragma unroll
      for (int e = 0; e < 8; ++e) fpk[mi][e] = 0u;
#pragma unroll 1
    for (int i = 0; i < 3; ++i) {
      unsigned gpk[4][8];
      {
        f32x16 ga[4][1];
        zero_acc<1>(ga);
        const u16* yb = (const u16*)(wsp(p) + (i == 0 ? OFF_YCONV : i == 1 ? OFF_YMLA : OFF_YNSA));
        const u16* wbb = wl + (i == 0 ? W_BC : i == 1 ? W_BM : W_BN);
        pre = gemm_acc_chain<1>(h + (size_t)m0 * 1024, 1024, wl + W_IN + (size_t)(i * 1024 + n0) * 1024, 1024, 1024, ga, lds, pre,
                                yb + (size_t)m0 * 512, 512, wbb + (size_t)n0 * 512, 512);
#pragma unroll
        for (int mi = 0; mi < 4; ++mi)
#pragma unroll
          for (int e = 0; e < 8; ++e) gpk[mi][e] = pack2(sigmoidf_(ga[mi][0][2 * e]), sigmoidf_(ga[mi][0][2 * e + 1]));
      }
      f32x16 ba[4][1];
      zero_acc<1>(ba);
      const u16* y = (const u16*)(wsp(p) + (i == 0 ? OFF_YCONV : i == 1 ? OFF_YMLA : OFF_YNSA));
      const u16* wb = wl + (i == 0 ? W_BC : i == 1 ? W_BM : W_BN);
      {
        const bool last = (i == 2);
        const u16* nA = last ? (has_next ? h + (size_t)(mt2 * 256) * 1024 : nullptr) : h + (size_t)m0 * 1024;
        const u16* nB = last ? wl + W_IN + (size_t)(nt2 * 128) * 1024 : wl + W_IN + (size_t)((i + 1) * 1024 + n0) * 1024;
        const int nb = gemm_acc_chain<1>(y + (size_t)m0 * 512, 512, wb + (size_t)n0 * 512, 512, 512, ba, lds, pre, nA, 1024, nB, 1024);
        pre = nA ? nb : -1;
      }
#pragma unroll
      for (int mi = 0; mi < 4; ++mi)
#pragma unroll
        for (int e = 0; e < 8; ++e)
          fpk[mi][e] = pack2(bflo(fpk[mi][e]) + bflo(gpk[mi][e]) * ba[mi][0][2 * e], bfhi(fpk[mi][e]) + bfhi(gpk[mi][e]) * ba[mi][0][2 * e + 1]);
    }
    {
      const int tid = otid(), lane = tid & 63, w = tid >> 6, r = lane & 31, hh = lane >> 5, wm = w >> 2, wn = w & 3;
#pragma unroll
      for (int mi = 0; mi < 4; ++mi)
#pragma unroll
        for (int g4 = 0; g4 < 4; ++g4) {
          const int m = m0 + 128 * wm + 32 * mi + 8 * g4 + 4 * hh;
          const int n = n0 + 32 * wn + r;
          u16* q = merged + (size_t)m * 1024 + n;
          q[0] = (u16)(fpk[mi][2 * g4] & 0xffffu);
          q[1024] = (u16)(fpk[mi][2 * g4] >> 16);
          q[2048] = (u16)(fpk[mi][2 * g4 + 1] & 0xffffu);
          q[3072] = (u16)(fpk[mi][2 * g4 + 1] >> 16);
        }
    }
  }
}

DI void gemm_phase(const u16* A, int lda, const u16* Bt, int K, int Ntiles, u16* C, int ldc, char* lds) {
  const int ntot = 128 * Ntiles;
  bool pre = false;
  for (int j = 0; j * (int)gridDim.x < ntot; ++j) {
    int mt, nt;
    if (!tile_mn(j, Ntiles, ntot, mt, nt)) continue;
    const int m0 = mt * 256, n0 = nt * 256;
    int mt2 = 0, nt2 = 0;
    const bool has_next = ((j + 1) * (int)gridDim.x < ntot) && tile_mn(j + 1, Ntiles, ntot, mt2, nt2);
    f32x4m acc[2][2][4][2];
    zero_acc8(acc);
    gemm8_acc(A + (size_t)m0 * lda, lda, Bt + (size_t)n0 * K, K, K, acc, lds, pre);
    if (has_next) gemm8_prologue(A + (size_t)(mt2 * 256) * lda, lda, Bt + (size_t)(nt2 * 256) * K, K, lds);
    pre = has_next;
    epi8_apply(acc, m0, n0, [&](int m, int n, float v0, float v1, float v2, float v3) { store_rows(C, ldc, m, n, v0, v1, v2, v3); });
  }
}

DI void phaseJ(const Params& p, int l) {
  u16* U = (u16*)(wsp(p) + OFF_U);
  const float* cw = (const float*)inp(p, 21) + (size_t)l * 3 * DFF;
  const float* cb = (const float*)inp(p, 22) + (size_t)l * DFF;
  const int nthr = gridDim.x * 512;
  constexpr int RUN = 16;
  for (int idx = blockIdx.x * 512 + otid(); idx < (T / RUN) * 352; idx += nthr) {
    const int run = idx / 352, c0 = (idx % 352) * 8;
    const int t0 = run * RUN, s0 = t0 & (S - 1);
    float w[3][8], bias[8], a0[8], a1[8];
#pragma unroll
    for (int k = 0; k < 3; ++k) {
      const f32x4 x0 = *(const f32x4*)(cw + k * DFF + c0), x1 = *(const f32x4*)(cw + k * DFF + c0 + 4);
      w[k][0] = x0.x; w[k][1] = x0.y; w[k][2] = x0.z; w[k][3] = x0.w; w[k][4] = x1.x; w[k][5] = x1.y; w[k][6] = x1.z; w[k][7] = x1.w;
    }
    {
      const f32x4 x0 = *(const f32x4*)(cb + c0), x1 = *(const f32x4*)(cb + c0 + 4);
      bias[0] = x0.x; bias[1] = x0.y; bias[2] = x0.z; bias[3] = x0.w; bias[4] = x1.x; bias[5] = x1.y; bias[6] = x1.z; bias[7] = x1.w;
    }
    {
      u32x4 u0 = mk_u4(0u, 0u, 0u, 0u), u1 = mk_u4(0u, 0u, 0u, 0u);
      if (s0 > 0) {
        u0 = *(const u32x4*)(U + (size_t)(t0 - 2) * 5632 + c0);
        u1 = *(const u32x4*)(U + (size_t)(t0 - 1) * 5632 + c0);
      }
      a0[0] = bflo(u0.x); a0[1] = bfhi(u0.x); a0[2] = bflo(u0.y); a0[3] = bfhi(u0.y); a0[4] = bflo(u0.z); a0[5] = bfhi(u0.z); a0[6] = bflo(u0.w); a0[7] = bfhi(u0.w);
      a1[0] = bflo(u1.x); a1[1] = bfhi(u1.x); a1[2] = bflo(u1.y); a1[3] = bfhi(u1.y); a1[4] = bflo(u1.z); a1[5] = bfhi(u1.z); a1[6] = bflo(u1.w); a1[7] = bfhi(u1.w);
    }
    for (int tb = 0; tb < RUN; tb += 8) {
      u32x4 uas[8], ubs[8];
#pragma unroll
      for (int q = 0; q < 8; ++q) {
        const u16* rowp = U + (size_t)(t0 + tb + q) * 5632 + c0;
        uas[q] = __builtin_nontemporal_load((const u32x4*)rowp);
        ubs[q] = __builtin_nontemporal_load((const u32x4*)(rowp + DFF));
      }
#pragma unroll
      for (int q = 0; q < 8; ++q) {
        const u32x4 ua = uas[q], ub = ubs[q];
        const float a2[8] = {bflo(ua.x), bfhi(ua.x), bflo(ua.y), bfhi(ua.y), bflo(ua.z), bfhi(ua.z), bflo(ua.w), bfhi(ua.w)};
        const float bv[8] = {bflo(ub.x), bfhi(ub.x), bflo(ub.y), bfhi(ub.y), bflo(ub.z), bfhi(ub.z), bflo(ub.w), bfhi(ub.w)};
        float z[8];
#pragma unroll
        for (int j = 0; j < 8; ++j) {
          const float x = bias[j] + w[0][j] * a0[j] + w[1][j] * a1[j] + w[2][j] * a2[j];
          const float u = 0.7978845608028654f * (x + 0.044715f * x * x * x);
          const float th = 1.f - 2.f * __builtin_amdgcn_rcpf(__expf(2.f * u) + 1.f);
          z[j] = 0.5f * x * (1.f + th) * bv[j];
          a0[j] = a1[j];
          a1[j] = a2[j];
        }
        *(u32x4*)(U + (size_t)(t0 + tb + q) * 5632 + c0 + DFF) = mk_u4(pack2(z[0], z[1]), pack2(z[2], z[3]), pack2(z[4], z[5]), pack2(z[6], z[7]));
      }
    }
  }
}

#define XB_TMO      128
#define XB_XCNT(j)  (256  + 64 * (j))
#define XB_XSUB(j)  (1280 + 64 * (j))
#define XB_XGEN(j)  (2304 + 64 * (j))
#define XB_TOP      3328
#define XB_TOPGEN   3392
#define XCD_BAR_WORDS 3456
#define XB_SPIN_CAP (1u << 20)
#define LAS __attribute__((address_space(3)))
DI unsigned xb_ld(unsigned* p) { return __hip_atomic_load(p, __ATOMIC_RELAXED, __HIP_MEMORY_SCOPE_AGENT); }
DI unsigned xb_add(unsigned* p, unsigned v) { return __hip_atomic_fetch_add(p, v, __ATOMIC_RELAXED, __HIP_MEMORY_SCOPE_AGENT); }
DI unsigned xb_xcc_id() { return (unsigned)__builtin_amdgcn_s_getreg((3 << 11) | 20) & 0xFu; }
#define XB_SPIN(cond, bar) do { unsigned _sp = 0; while (cond) { __builtin_amdgcn_s_sleep(1); \
    if ((++_sp & 255u) == 0u) { if (xb_ld(&(bar)[XB_TMO])) break; if (_sp > XB_SPIN_CAP) { atomicAdd(&(bar)[XB_TMO], 1u); break; } } } } while (0)
struct XcdBarrier { unsigned* bar; unsigned x; volatile LAS unsigned* st; };
DI XcdBarrier xcd_barrier_post(unsigned* bar, volatile LAS unsigned* st) {
  XcdBarrier b; b.bar = bar; b.x = xb_xcc_id(); b.st = st;
  if (threadIdx.x == 0) (void)xb_add(&bar[XB_XCNT(b.x)], 1u);
  return b;
}
DI void xcd_barrier_complete(unsigned* bar, unsigned x, unsigned& nloc, unsigned& nx) {
  const unsigned G = gridDim.x * gridDim.y * gridDim.z;
  unsigned sum, cnt, mine, sp = 0u;
  for (;;) {
    sum = 0u; cnt = 0u; mine = 0u;
#pragma unroll
    for (unsigned j = 0; j < 16; ++j) { const unsigned c = xb_ld(&bar[XB_XCNT(j)]); sum += c; cnt += (c > 0u) ? 1u : 0u; mine = (j == x) ? c : mine; }
    if (sum == G) break;
    __builtin_amdgcn_s_sleep(1);
    if ((++sp & 255u) == 0u) { if (xb_ld(&bar[XB_TMO])) break; if (sp > XB_SPIN_CAP) { atomicAdd(&bar[XB_TMO], 1u); break; } }
  }
  nloc = mine > 0u ? mine : 1u; nx = cnt > 0u ? cnt : 1u;
}
DI void xcd_barrier(const XcdBarrier& b) {
  asm volatile("s_waitcnt vmcnt(0)" ::: "memory");
  __syncthreads();
  if (threadIdx.x == 0) {
    unsigned* bar = b.bar;
    __builtin_amdgcn_s_waitcnt(0);
    unsigned nloc = b.st[0], nx = b.st[1];
    if (nloc == 0u) { xcd_barrier_complete(bar, b.x, nloc, nx); b.st[0] = nloc; b.st[1] = nx; }
    const unsigned old = xb_add(&bar[XB_XSUB(b.x)], 1u);
    const unsigned gen = old / nloc;
    if (old + 1u == (gen + 1u) * nloc) {
      __builtin_amdgcn_fence(__ATOMIC_RELEASE, "agent");
      asm volatile("s_waitcnt vmcnt(0)" ::: "memory");
      const unsigned og = xb_add(&bar[XB_TOP], 1u);
      const unsigned tg = og / nx;
      if (og + 1u == (tg + 1u) * nx) xb_add(&bar[XB_TOPGEN], 1u);
      else XB_SPIN(xb_ld(&bar[XB_TOPGEN]) == tg, bar);
      __builtin_amdgcn_fence(__ATOMIC_ACQUIRE, "agent");
      xb_add(&bar[XB_XGEN(b.x)], 1u);
      asm volatile("s_waitcnt vmcnt(0)" ::: "memory");
    } else {
      XB_SPIN(xb_ld(&bar[XB_XGEN(b.x)]) == gen, bar);
      __builtin_amdgcn_fence(__ATOMIC_ACQUIRE, "agent");
      asm volatile("s_waitcnt vmcnt(0)" ::: "memory");
    }
  }
  __syncthreads();
}

__global__ void __launch_bounds__(512, 2) fwd_megakernel(Params p) {
  __shared__ __attribute__((aligned(1024))) char lds[131072 + 1024];
  cg::grid_group grid = cg::this_grid();
  if (threadIdx.x < 4) ((unsigned*)(lds + 131072))[threadIdx.x] = 0u;
  __syncthreads();
  XcdBarrier xb = xcd_barrier_post((unsigned*)(p.ws + OFF_BAR), (volatile LAS unsigned*)(lds + 131072));
  const int lane = otid() & 63, gw = blockIdx.x * 8 + (otid() >> 6), nw = gridDim.x * 8;
  phase0(p, lds);
  grid.sync();
  for (int l = 0; l < 2; ++l) {
    const u16* wl = (const u16*)wsp(p) + (size_t)l * W_LAYER;
    phaseA(p, l, lds);
    xcd_barrier(xb);
    phaseB(p, l);
    xcd_barrier(xb);
    phaseC(p, l, lds);
    xcd_barrier(xb);
    for (int j = 0; j * (int)gridDim.x < 2048; ++j) {
      const int t2 = j * gridDim.x + blockIdx.x;
      if (t2 >= 2048) break;
      if ((blockIdx.x + j) & 1) {
        cmp_tile(p, t2 >> 1, lds);
        __threadfence_block();
        __syncthreads();
        nsa_tile(p, t2 >> 1, lds);
      } else {
        mla_tile(p, t2 >> 1, lds);
      }
    }
    xcd_barrier(xb);
    phaseF(p, l, lds);
    xcd_barrier(xb);
    gemm_phase((const u16*)(wsp(p) + OFF_MERGED), 1024, wl + W_OUT, 1024, 4, (u16*)(wsp(p) + OFF_O), 1024, lds);
    xcd_barrier(xb);
    {
      const float* xs = l == 0 ? (const float*)inp(p, 0) : p.out;
      rowpass_all(xs, p.out, (const u16*)(wsp(p) + OFF_O), (const float*)inp(p, 3) + l * 1024, (const float*)inp(p, 18) + l * 1024, (u16*)(wsp(p) + OFF_H));
    }
    xcd_barrier(xb);
    gemm_phase((const u16*)(wsp(p) + OFF_H), 1024, wl + W_UP, 1024, 22, (u16*)(wsp(p) + OFF_U), 5632, lds);
    xcd_barrier(xb);
    phaseJ(p, l);
    xcd_barrier(xb);
    gemm_phase((const u16*)(wsp(p) + OFF_U) + DFF, 5632, wl + W_DOWN, DFF, 4, (u16*)(wsp(p) + OFF_H), 1024, lds);
    xcd_barrier(xb);
    {
      const float* gnext = l == 0 ? (const float*)inp(p, 2) + 1024 : nullptr;
      rowpass_all(p.out, p.out, (const u16*)(wsp(p) + OFF_H), (const float*)inp(p, 19) + l * 1024, gnext, (u16*)(wsp(p) + OFF_H));
    }
    if (l == 0) xcd_barrier(xb);
  }
}

extern "C" void kernel_launch(void* const* d_in, const int* in_sizes, int n_in, void* d_out, int out_size, void* d_ws, size_t ws_size,
                              hipStream_t stream) {
  static int grid_blocks = 0;
  if (!grid_blocks) {
    int dev = 0, cus = 0, per_cu = 0;
    hipGetDevice(&dev);
    hipDeviceGetAttribute(&cus, hipDeviceAttributeMultiprocessorCount, dev);
    hipOccupancyMaxActiveBlocksPerMultiprocessor(&per_cu, fwd_megakernel, 512, 0);
    if (per_cu > 1) per_cu = 1;
    grid_blocks = cus * per_cu;
  }
  Params p{};
  for (int i = 0; i < 24; ++i) p.in[i] = d_in[i];
  p.out = (float*)d_out;
  p.ws = (char*)d_ws;
  hipMemsetAsync((char*)d_ws + OFF_BAR, 0, XCD_BAR_WORDS * sizeof(unsigned), stream);
  void* args[] = {&p};
  hipError_t e = hipLaunchCooperativeKernel((void*)fwd_megakernel, dim3(grid_blocks), dim3(512), args, 0, stream);
  if (e != hipSuccess) fprintf(stderr, "cooperative launch failed: %s (grid %d)\n", hipGetErrorString(e), grid_blocks);
}
```
